# Optimizing an MI355X kernel written in HIP

```python
import math
import jax
import jax.numpy as jnp
from jax import lax
import numpy as np

D_MODEL = 1024
BATCH = 8
SEQ = 8192
DEPTH = 1

CTX_LEN = 256
GRID_W = 64
EPS = 1e-6

HY_WIDTH = D_MODEL
HY_EMB = 33
HY_BANDS = (HY_EMB - 1) // 2
HY_ORDER = 64
HY_FAST_DECAY = 0.3
HY_SLOW_DECAY = 1.5
HY_TARGET = 1e-2

RET_HEADS = 4
RET_DK = D_MODEL // 8
RET_DV = 2 * RET_DK
RET_CHUNK = 128
ROPE_BASE = 10000.0

PEER_HEADS = 8
PEER_N_KEYS = 128
PEER_N_EXPERTS = PEER_N_KEYS * PEER_N_KEYS
PEER_TOPK = 16
PEER_DK = 128
PEER_BLOCK = 128

HY_COLS = 3 * HY_WIDTH
RQ_COLS = RET_HEADS * RET_DK
RV_COLS = RET_HEADS * RET_DV
PROJ_SPLITS = [HY_COLS,
               HY_COLS + RQ_COLS,
               HY_COLS + 2 * RQ_COLS,
               HY_COLS + 2 * RQ_COLS + RV_COLS,
               HY_COLS + 2 * RQ_COLS + 2 * RV_COLS,
               HY_COLS + 2 * RQ_COLS + 2 * RV_COLS + D_MODEL]
PROJ_WIDTH = HY_COLS + 2 * RQ_COLS + 2 * RV_COLS + 2 * D_MODEL

kernel_name = 'hyena_retention_peer_hybrid_dit'


def rms_norm(x, gain):
    xf = x.astype(jnp.float32)
    y = xf * lax.rsqrt(jnp.mean(xf * xf, axis=-1, keepdims=True) + EPS)
    return (y * gain.astype(jnp.float32)).astype(x.dtype)


def modulate(h, shift, scale):
    return h * (1.0 + scale) + shift


def short_conv3(z, w, b):
    zp = jnp.pad(z, ((0, 0), (1, 1), (0, 0)))
    return zp[:, :-2] * w[0] + zp[:, 1:-1] * w[1] + zp[:, 2:] * w[2] + b


def hyena_filter(length, lp):
    f32 = jnp.float32
    t = jnp.linspace(0.0, 1.0, length, dtype=f32)[:, None]
    bands = jnp.linspace(1e-4, HY_BANDS - 1, HY_BANDS, dtype=f32)[None, :]
    w = (2.0 * math.pi / length) * jnp.arange(length, dtype=f32)[:, None]
    z = jnp.concatenate([t, jnp.cos(bands * w), -jnp.sin(bands * w)], axis=-1)
    freq = lp['hy_sin_freq'].astype(f32)
    h = jnp.sin(freq * (z @ lp['hy_fw1'].astype(f32) + lp['hy_fb1'].astype(f32)))
    h = jnp.sin(freq * (h @ lp['hy_fw2'].astype(f32) + lp['hy_fb2'].astype(f32)))
    h = jnp.sin(freq * (h @ lp['hy_fw3'].astype(f32) + lp['hy_fb3'].astype(f32)))
    h = (h @ lp['hy_fw4'].astype(f32)).reshape(length, 2, HY_WIDTH)
    window = jnp.exp(-t * jnp.abs(lp['hy_deltas'].astype(f32)))
    h = h * window[:, None, :]
    kern = jnp.concatenate([h[:, 0], jnp.zeros((1, HY_WIDTH), f32), h[:0:-1, 1]], axis=0)
    return kern / (jnp.sum(jnp.abs(kern), axis=0, keepdims=True) + EPS)


def hyena_long_conv(u, kern, skip):
    length = u.shape[1]
    uf = u.astype(jnp.float32)
    spec = jnp.fft.rfft(uf, n=2 * length, axis=1) * jnp.fft.rfft(kern, n=2 * length, axis=0)[None]
    y = jnp.fft.irfft(spec, n=2 * length, axis=1)[:, :length]
    return (y + uf * skip.astype(jnp.float32)).astype(u.dtype)


def hyena_branch(z, lp):
    length = z.shape[1]
    z = short_conv3(z, lp['hy_conv_w'], lp['hy_conv_b'])
    x0, x1, v = jnp.split(z, 3, axis=-1)
    kern = hyena_filter(length, lp)
    return hyena_long_conv(v * x1, kern, lp['hy_bias']) * x0


def axial_rotary(x, rows, cols):
    half = RET_DK // 2
    nf = half // 2
    inv = ROPE_BASE ** (-jnp.arange(nf, dtype=jnp.float32) / nf)

    def rot(xp, pos):
        ang = pos[:, None] * inv[None, :]
        cos = jnp.cos(ang)[None, :, None, :].astype(x.dtype)
        sin = jnp.sin(ang)[None, :, None, :].astype(x.dtype)
        x1, x2 = xp[..., :nf], xp[..., nf:]
        return jnp.concatenate([x1 * cos - x2 * sin, x1 * sin + x2 * cos], axis=-1)

    return jnp.concatenate([rot(x[..., :half], rows), rot(x[..., half:], cols)], axis=-1)


def retention_scan(q, k, v, log_gamma, state0):
    f32 = jnp.float32
    bsz, length = q.shape[0], q.shape[1]
    n_chunks = length // RET_CHUNK

    def chunks(a):
        return a.astype(f32).reshape(bsz, n_chunks, RET_CHUNK, RET_HEADS, a.shape[-1]).transpose(1, 0, 3, 2, 4)

    lg = log_gamma.astype(f32)[:, None]
    idx = jnp.arange(RET_CHUNK, dtype=f32)
    rel = idx[:, None] - idx[None, :]
    decay_in = jnp.where(rel >= 0, jnp.exp(lg[:, :, None] * jnp.maximum(rel, 0.0)), 0.0)
    xi = jnp.exp(lg * (idx + 1.0))[:, :, None]
    zeta = jnp.exp(lg * (RET_CHUNK - 1.0 - idx))[:, :, None]
    g_chunk = jnp.exp(lg * RET_CHUNK)[:, :, None]

    def step(state, qkv):
        qc, kc, vc = qkv
        scores = jnp.einsum('bhid,bhjd->bhij', qc, kc) * decay_in
        out = (jnp.einsum('bhij,bhjv->bhiv', scores, vc)
               + jnp.einsum('bhid,bhdv->bhiv', qc, state) * xi)
        state = state * g_chunk + jnp.einsum('bhjd,bhjv->bhdv', kc * zeta, vc)
        return state, out

    state, out = lax.scan(step, state0, (chunks(q), chunks(k), chunks(v)))
    out = out.transpose(1, 0, 3, 2, 4).reshape(bsz, length, RET_HEADS, RET_DV)
    return out, state


def bi_retention(q, k, v, lg_f, lg_b, state_f, state_b):
    o_f, s_f = retention_scan(q, k, v, lg_f, state_f)
    o_b, s_b = retention_scan(jnp.flip(q, 1), jnp.flip(k, 1), jnp.flip(v, 1), lg_b, state_b)
    return o_f + jnp.flip(o_b, 1), s_f, s_b


def context_states(k, v, lg_f, lg_b):
    f32 = jnp.float32
    n = k.shape[1]
    pos = jnp.arange(n, dtype=f32)
    w_f = jnp.exp(lg_f.astype(f32)[:, None] * (n - 1.0 - pos))
    w_b = jnp.exp(lg_b.astype(f32)[:, None] * pos)
    kf, vf = k.astype(f32), v.astype(f32)
    s_f = jnp.einsum('blhd,hl,blhv->bhdv', kf, w_f, vf)
    s_b = jnp.einsum('blhd,hl,blhv->bhdv', kf, w_b, vf)
    return s_f, s_b


def retention_readout(o, g):
    bsz, length = o.shape[0], o.shape[1]
    y = o * lax.rsqrt(jnp.mean(o * o, axis=-1, keepdims=True) + EPS)
    gate = jax.nn.silu(g).reshape(bsz, length, RET_HEADS, RET_DV)
    return (y.astype(g.dtype) * gate).reshape(bsz, length, RET_HEADS * RET_DV)


def token_mixer(h_lat, h_ctx, lp, rows, cols, with_ctx_out):
    f32 = jnp.float32
    bsz = h_lat.shape[0]
    hy_l, q_l, k_l, v_l, g_l, ah_l, ar_l = jnp.split(h_lat @ lp['w_in'], PROJ_SPLITS, axis=-1)
    hy_c, q_c, k_c, v_c, g_c, ah_c, ar_c = jnp.split(h_ctx @ lp['w_in'], PROJ_SPLITS, axis=-1)
    scale = RET_DK ** -0.5

    def heads(a, d):
        return a.reshape(a.shape[0], a.shape[1], RET_HEADS, d)

    lg_f, lg_b = lp['ret_log_decay_f'], lp['ret_log_decay_b']
    k_ch = heads(k_c, RET_DK) * scale
    v_ch = heads(v_c, RET_DV)
    if with_ctx_out:
        zero = jnp.zeros((bsz, RET_HEADS, RET_DK, RET_DV), f32)
        o_c, s_f, s_b = bi_retention(heads(q_c, RET_DK), k_ch, v_ch, lg_f, lg_b, zero, zero)
    else:
        s_f, s_b = context_states(k_ch, v_ch, lg_f, lg_b)

    q_lh = axial_rotary(heads(q_l, RET_DK), rows, cols)
    k_lh = axial_rotary(heads(k_l, RET_DK), rows, cols) * scale
    o_l, _, _ = bi_retention(q_lh, k_lh, heads(v_l, RET_DV), lg_f, lg_b, s_f, s_b)

    def merge(hy_proj, o, g, a_h, a_r):
        y_h = hyena_branch(hy_proj, lp) @ lp['w_hy_out']
        y_r = retention_readout(o, g) @ lp['w_ret_out']
        m = jax.nn.sigmoid(a_h) * y_h + jax.nn.sigmoid(a_r) * y_r
        return m @ lp['w_o']

    out_lat = merge(hy_l, o_l, g_l, ah_l, ar_l)
    out_ctx = merge(hy_c, o_c, g_c, ah_c, ar_c) if with_ctx_out else None
    return out_lat, out_ctx


def peer(h, w_query, sub_keys, expert_u, expert_v):
    bsz, length, d = h.shape
    blocks = h.reshape(-1, PEER_BLOCK, d)

    def block_fn(xb):
        q = (xb @ w_query).astype(jnp.float32).reshape(PEER_BLOCK, PEER_HEADS, 2, PEER_DK // 2)
        s = jnp.einsum('phcd,hcnd->phcn', q, sub_keys.astype(jnp.float32))
        s1, i1 = lax.top_k(s[:, :, 0], PEER_TOPK)
        s2, i2 = lax.top_k(s[:, :, 1], PEER_TOPK)
        cand = (s1[..., :, None] + s2[..., None, :]).reshape(PEER_BLOCK, PEER_HEADS, PEER_TOPK * PEER_TOPK)
        cand_idx = (i1[..., :, None] * PEER_N_KEYS + i2[..., None, :]).reshape(PEER_BLOCK, PEER_HEADS, PEER_TOPK * PEER_TOPK)
        top_s, top_pos = lax.top_k(cand, PEER_TOPK)
        eidx = jnp.take_along_axis(cand_idx, top_pos, axis=-1)
        gates = jax.nn.softmax(top_s, axis=-1).astype(xb.dtype)
        u = jnp.take(expert_u, eidx, axis=0)
        act = jax.nn.gelu(jnp.einsum('phkd,pd->phk', u, xb))
        v = jnp.take(expert_v, eidx, axis=0)
        return jnp.einsum('phk,phkd->pd', gates * act, v)

    return lax.map(block_fn, blocks).reshape(bsz, length, d)


def setup_inputs(seed: int = 0) -> dict:
    key = jax.random.key(seed)
    ks = jax.random.split(key, 32)
    f32 = jnp.float32

    def nrm(k, shape, s):
        return jax.random.normal(k, shape, f32) * s

    max_decay = math.log(HY_TARGET) / HY_FAST_DECAY
    min_decay = math.log(HY_TARGET) / HY_SLOW_DECAY
    ret_base = jnp.log1p(-(2.0 ** (-5.0 - jnp.arange(RET_HEADS, dtype=f32))))
    return {
        'x': nrm(ks[0], (BATCH, SEQ, D_MODEL), 1.0),
        'c': nrm(ks[1], (BATCH, D_MODEL), 1.0),
        'ctx': nrm(ks[2], (BATCH, CTX_LEN, D_MODEL), 1.0),
        'c_ctx': nrm(ks[3], (D_MODEL,), 1.0),
        'w_ada': nrm(ks[4], (DEPTH, D_MODEL, 6 * D_MODEL), 0.5 * D_MODEL ** -0.5),
        'b_ada': nrm(ks[5], (DEPTH, 6 * D_MODEL), 0.01),
        'norm1': 1.0 + nrm(ks[6], (DEPTH, D_MODEL), 0.02),
        'norm2': 1.0 + nrm(ks[7], (DEPTH, D_MODEL), 0.02),
        'w_in': nrm(ks[8], (DEPTH, D_MODEL, PROJ_WIDTH), D_MODEL ** -0.5),
        'hy_conv_w': nrm(ks[9], (DEPTH, 3, HY_COLS), 3 ** -0.5),
        'hy_conv_b': nrm(ks[10], (DEPTH, HY_COLS), 0.01),
        'hy_fw1': nrm(ks[11], (DEPTH, HY_EMB, HY_ORDER), HY_EMB ** -0.5),
        'hy_fb1': nrm(ks[12], (DEPTH, HY_ORDER), 0.1),
        'hy_fw2': nrm(ks[13], (DEPTH, HY_ORDER, HY_ORDER), HY_ORDER ** -0.5),
        'hy_fb2': nrm(ks[14], (DEPTH, HY_ORDER), 0.1),
        'hy_fw3': nrm(ks[15], (DEPTH, HY_ORDER, HY_ORDER), HY_ORDER ** -0.5),
        'hy_fb3': nrm(ks[16], (DEPTH, HY_ORDER), 0.1),
        'hy_fw4': nrm(ks[17], (DEPTH, HY_ORDER, 2 * HY_WIDTH), HY_ORDER ** -0.5),
        'hy_sin_freq': 1.0 + nrm(ks[18], (DEPTH, HY_ORDER), 0.02),
        'hy_deltas': jnp.linspace(min_decay, max_decay, HY_WIDTH, dtype=f32)[None, :] * (1.0 + nrm(ks[19], (DEPTH, HY_WIDTH), 0.02)),
        'hy_bias': nrm(ks[20], (DEPTH, HY_WIDTH), 0.5),
        'ret_log_decay_f': ret_base[None, :] * jnp.exp(nrm(ks[21], (DEPTH, RET_HEADS), 0.1)),
        'ret_log_decay_b': ret_base[None, :] * jnp.exp(nrm(ks[22], (DEPTH, RET_HEADS), 0.1)),
        'w_hy_out': nrm(ks[23], (DEPTH, HY_WIDTH, D_MODEL), HY_WIDTH ** -0.5),
        'w_ret_out': nrm(ks[24], (DEPTH, RV_COLS, D_MODEL), RV_COLS ** -0.5),
        'w_o': nrm(ks[25], (DEPTH, D_MODEL, D_MODEL), D_MODEL ** -0.5),
        'peer_w_query': nrm(ks[26], (DEPTH, D_MODEL, PEER_HEADS * PEER_DK), D_MODEL ** -0.5),
        'peer_sub_keys': nrm(ks[27], (DEPTH, PEER_HEADS, 2, PEER_N_KEYS, PEER_DK // 2), (PEER_DK // 2) ** -0.5),
        'peer_u': nrm(ks[28], (DEPTH, PEER_N_EXPERTS, D_MODEL), D_MODEL ** -0.5),
        'peer_v': nrm(ks[29], (DEPTH, PEER_N_EXPERTS, D_MODEL), PEER_HEADS ** -0.5),
        'final_norm': 1.0 + nrm(ks[30], (D_MODEL,), 0.02),
    }


def reference(x, c, ctx, c_ctx, w_ada, b_ada, norm1, norm2, w_in, hy_conv_w, hy_conv_b,
              hy_fw1, hy_fb1, hy_fw2, hy_fb2, hy_fw3, hy_fb3, hy_fw4, hy_sin_freq, hy_deltas, hy_bias,
              ret_log_decay_f, ret_log_decay_b, w_hy_out, w_ret_out, w_o,
              peer_w_query, peer_sub_keys, peer_u, peer_v, final_norm):
    n_rows = x.shape[1] // GRID_W
    rows = jnp.repeat(jnp.arange(n_rows, dtype=jnp.float32), GRID_W)
    cols = jnp.tile(jnp.arange(GRID_W, dtype=jnp.float32), n_rows)
    x_lat, x_ctx = x, ctx
    for layer in range(DEPTH):
        lp = {
            'w_in': w_in[layer], 'hy_conv_w': hy_conv_w[layer], 'hy_conv_b': hy_conv_b[layer],
            'hy_fw1': hy_fw1[layer], 'hy_fb1': hy_fb1[layer], 'hy_fw2': hy_fw2[layer], 'hy_fb2': hy_fb2[layer],
            'hy_fw3': hy_fw3[layer], 'hy_fb3': hy_fb3[layer], 'hy_fw4': hy_fw4[layer],
            'hy_sin_freq': hy_sin_freq[layer], 'hy_deltas': hy_deltas[layer], 'hy_bias': hy_bias[layer],
            'ret_log_decay_f': ret_log_decay_f[layer], 'ret_log_decay_b': ret_log_decay_b[layer],
            'w_hy_out': w_hy_out[layer], 'w_ret_out': w_ret_out[layer], 'w_o': w_o[layer],
        }
        last = layer == DEPTH - 1
        mod_l = (jax.nn.silu(c) @ w_ada[layer] + b_ada[layer])[:, None, :]
        mod_c = (jax.nn.silu(c_ctx) @ w_ada[layer] + b_ada[layer])[None, None, :]
        sh1, sc1, g1, sh2, sc2, g2 = jnp.split(mod_l, 6, axis=-1)
        csh1, csc1, cg1, csh2, csc2, cg2 = jnp.split(mod_c, 6, axis=-1)

        h_lat = modulate(rms_norm(x_lat, norm1[layer]), sh1, sc1)
        h_ctx = modulate(rms_norm(x_ctx, norm1[layer]), csh1, csc1)
        mix_lat, mix_ctx = token_mixer(h_lat, h_ctx, lp, rows, cols, not last)
        x_lat = x_lat + g1 * mix_lat
        h_lat = modulate(rms_norm(x_lat, norm2[layer]), sh2, sc2)
        x_lat = x_lat + g2 * peer(h_lat, peer_w_query[layer], peer_sub_keys[layer], peer_u[layer], peer_v[layer])
        if not last:
            x_ctx = x_ctx + cg1 * mix_ctx
            h_ctx = modulate(rms_norm(x_ctx, norm2[layer]), csh2, csc2)
            x_ctx = x_ctx + cg2 * peer(h_ctx, peer_w_query[layer], peer_sub_keys[layer], peer_u[layer], peer_v[layer])
    return rms_norm(x_lat, final_norm)
```

```cpp
#include <hip/hip_runtime.h>
#include <hip/hip_cooperative_groups.h>
#include <cstdio>
#include <cstdint>
namespace pg8 {
#define PG8_LAS __attribute__((address_space(3)))
typedef unsigned short bf16_t;
typedef short bf16x8 __attribute__((ext_vector_type(8)));
typedef float f32x4 __attribute__((ext_vector_type(4)));
typedef unsigned u32x4 __attribute__((ext_vector_type(4)));
constexpr int BM = 256, BK = 64, HALF = 128, HTB = HALF * BK * 2  , STAGE_BYTES = 8 * HTB, NXCD = 8, WGM = 8;

__host__ __device__ __forceinline__ int lds_byte(int r, int c) { const int st = (r >> 4) * 2 + (c >> 5), rr = r & 15, cc = c & 31, ob = rr * 64 + cc * 2; return st * 1024 + (ob ^ (((ob >> 9) & 1) << 5)); }
__host__ __device__ __forceinline__ void stage_rc(int b, int& R, int& C) { const int st = b / 1024, sb = b % 1024, swz = sb ^ (((sb >> 9) & 1) << 5); R = (st >> 1) * 16 + swz / 64; C = (st & 1) * 32 + (swz % 64) / 2; }
__host__ __device__ __forceinline__ int perm32(int rho) { const int n = rho >> 4, i = rho & 15; return 8 * (i >> 2) + 4 * n + (i & 3); }

struct Unit { int pm, pn; };
struct Gemm { const bf16_t* A; const bf16_t* Bt; int M, N, K; };

struct StaticOrder {
    int nM, nN, nwg, G, c;
    __host__ __device__ void init(int M, int N, int G_, int c_) { nM = M / BM; nN = N / BM; nwg = nM * nN; G = G_; c = c_; }
    __host__ __device__ bool next(int i, Unit& u) const {
        const long L = (long)i * G + c; if (L >= nwg) return false;
        int wgid = (int)L; { const int q = nwg / NXCD, r = nwg % NXCD, xcd = wgid % NXCD, off = wgid / NXCD; wgid = (xcd < r ? xcd * (q + 1) : r * (q + 1) + (xcd - r) * q) + off; }
        const int nig = WGM * nN, gid = wgid / nig, fm = gid * WGM, gsz = (nM - fm) < WGM ? (nM - fm) : WGM;
        u.pm = fm + ((wgid % nig) % gsz); u.pn = (wgid % nig) / gsz; return true;
    }
    __device__ __forceinline__ void a_ready(const Unit&) const {}
    __device__ __forceinline__ void done(const Unit&) const {}
};
__device__ __forceinline__ unsigned cvt_pk_bf16(float lo, float hi) { unsigned r; asm volatile("v_cvt_pk_bf16_f32 %0, %1, %2" : "=v"(r) : "v"(lo), "v"(hi)); return r; }
typedef float f32x2 __attribute__((ext_vector_type(2)));
__device__ __forceinline__ f32x2 gelu_pk(f32x2 v) {
    const f32x2 av = __builtin_elementwise_abs(v), d = av * 0.2316418882f + 1.0f;
    f32x2 t; t.x = __builtin_amdgcn_rcpf(d.x); t.y = __builtin_amdgcn_rcpf(d.y);
    f32x2 q = t * 0.5307027145f + (-0.7265760135f); q = q * t + 0.7107068705f; q = q * t + (-0.142248368f); q = q * t + 0.127414796f; q = q * t;
    const f32x2 s = (v * v) * (-0.72134752044f);
    f32x2 e; e.x = __builtin_amdgcn_exp2f(s.x); e.y = __builtin_amdgcn_exp2f(s.y);
    const f32x2 m = v * (q * e), r = v - m;
    f32x2 o; o.x = v.x < 0.f ? m.x : r.x; o.y = v.y < 0.f ? m.y : r.y; return o;
}

struct EpiF32 {
    static constexpr bool PERM = false, AFTER_DRAIN = false;
    float* C; int ldc; const float* bias;
    __device__ __forceinline__ void operator()(const f32x4 (&acc)[2][2][4][2], const Unit& u, int wr, int wc, int fr, int fq) const {
        const int row0 = u.pm * BM + wr * 64 + fr, col0 = u.pn * BM + wc * 32 + 4 * fq;
        f32x4 bv[2][2];
#pragma unroll
        for (int bj = 0; bj < 2; ++bj)
#pragma unroll
            for (int n = 0; n < 2; ++n) bv[bj][n] = bias ? *(const f32x4*)(bias + col0 + bj * HALF + n * 16) : (f32x4){0.f, 0.f, 0.f, 0.f};
#pragma unroll
        for (int ai = 0; ai < 2; ++ai)
#pragma unroll
            for (int m = 0; m < 4; ++m) { float* rowp = C + (size_t)(row0 + ai * HALF + m * 16) * ldc + col0;
#pragma unroll
                for (int bj = 0; bj < 2; ++bj)
#pragma unroll
                    for (int n = 0; n < 2; ++n) *(f32x4*)(rowp + bj * HALF + n * 16) = acc[ai][bj][m][n] + bv[bj][n]; }
    }
};
template <int ACT  > struct EpiBf16 {
    static constexpr bool PERM = true, AFTER_DRAIN = false;
    bf16_t* O; int ldc; const float* bias; int split_cols; size_t split_stride;
    __device__ __forceinline__ void operator()(const f32x4 (&acc)[2][2][4][2], const Unit& u, int wr, int wc, int fr, int fq) const {
        const int row0 = u.pm * BM + wr * 64 + fr; int colt = u.pn * BM; bf16_t* base = O;
        if (split_cols) { const int t = colt / split_cols; base += (size_t)t * split_stride; colt -= t * split_cols; }
        const int col0 = colt + wc * 32 + 8 * fq, bcol0 = u.pn * BM + wc * 32 + 8 * fq;
        f32x4 bv[2][2];
#pragma unroll
        for (int bj = 0; bj < 2; ++bj)
#pragma unroll
            for (int n = 0; n < 2; ++n) bv[bj][n] = bias ? *(const f32x4*)(bias + bcol0 + bj * HALF + 4 * n) : (f32x4){0.f, 0.f, 0.f, 0.f};
#pragma unroll
        for (int ai = 0; ai < 2; ++ai)
#pragma unroll
            for (int m = 0; m < 4; ++m) { bf16_t* rowp = base + (size_t)(row0 + ai * HALF + m * 16) * ldc + col0;
#pragma unroll
                for (int bj = 0; bj < 2; ++bj) { f32x4 v0 = acc[ai][bj][m][0] + bv[bj][0], v1 = acc[ai][bj][m][1] + bv[bj][1];
                    if (ACT == 1) { f32x2 a = gelu_pk((f32x2){v0[0], v0[1]}), b = gelu_pk((f32x2){v0[2], v0[3]}), c = gelu_pk((f32x2){v1[0], v1[1]}), d = gelu_pk((f32x2){v1[2], v1[3]});
                        v0 = (f32x4){a.x, a.y, b.x, b.y}; v1 = (f32x4){c.x, c.y, d.x, d.y}; }
                    if (ACT == 2) {
#pragma unroll
                        for (int j = 0; j < 4; ++j) { v0[j] = 0.5f * v0[j] * (1.0f + erff(v0[j] * 0.70710678f)); v1[j] = 0.5f * v1[j] * (1.0f + erff(v1[j] * 0.70710678f)); } }
                    u32x4 w; w.x = cvt_pk_bf16(v0[0], v0[1]); w.y = cvt_pk_bf16(v0[2], v0[3]); w.z = cvt_pk_bf16(v1[0], v1[1]); w.w = cvt_pk_bf16(v1[2], v1[3]);
                    *(u32x4*)(rowp + bj * HALF) = w; } }
    }
};
template <class Epi, class Sched, bool STAMP = false>
__device__ __forceinline__ void gemm_phase(PG8_LAS unsigned char* lds, const Gemm g, const Sched& S, const Epi& E, unsigned long long* stamps) {
    const int tid = threadIdx.x, wid = __builtin_amdgcn_readfirstlane(tid >> 6), lane = tid & 63, wr = wid >> 2, wc = wid & 3, fr = lane & 15, fq = lane >> 4;
    const int K = g.K, nt = K / BK;
    int ts_lo = 0, ts_hi = 0, nts = 0; const unsigned long long rt_entry = STAMP ? (unsigned long long)wall_clock64() : 0ull;
#define PG8_STAMP() do { if (STAMP && wid == 0 && nts < 64) { const unsigned long long _c = (unsigned long long)clock64(); \
        ts_lo = (lane == nts) ? (int)(unsigned)_c : ts_lo; ts_hi = (lane == nts) ? (int)(unsigned)(_c >> 32) : ts_hi; ++nts; } } while (0)
    PG8_STAMP();
    unsigned voffA[2], voffB[2];
#pragma unroll
    for (int i = 0; i < 2; ++i) { int R, C; stage_rc(tid * 16 + i * 8192, R, C); const int Rb = Epi::PERM ? ((R & ~31) + perm32(R & 31)) : R;
        voffA[i] = (unsigned)(R * K + C) * 2u; voffB[i] = (unsigned)(Rb * K + C) * 2u; }
    const size_t kstep = (size_t)(BK * 2);
    const size_t hstep = (size_t)HALF * K * 2;
    const size_t tstep = 2 * hstep;
    const unsigned ldsw = (unsigned)wid * 1024u;
    const int aoff = lds_byte(wr * 64 + fr, fq * 8), boff = lds_byte(wc * 32 + fr, fq * 8);
#define PG8_SA(b, h) (((b) * 2 + (h)) * HTB)
#define PG8_SB(b, h) ((4 + (b) * 2 + (h)) * HTB)
#define PG8_STAGE(bufoff, gbase, voff) do { _Pragma("unroll") for (int _i = 0; _i < 2; ++_i) \
        __builtin_amdgcn_global_load_lds((const unsigned*)((const char*)(gbase) + (voff)[_i]), (PG8_LAS unsigned*)(lds + (bufoff) + ldsw + _i * 8192), 16, 0, 0); } while (0)
#define PG8_LDA(dst, b, h) do { _Pragma("unroll") for (int m = 0; m < 4; ++m) _Pragma("unroll") for (int k = 0; k < 2; ++k) dst[m][k] = *(const PG8_LAS bf16x8*)(lds + PG8_SA(b, h) + aoff + m * 2048 + k * 1024); } while (0)
#define PG8_LDB(dst, b, h) do { _Pragma("unroll") for (int n = 0; n < 2; ++n) _Pragma("unroll") for (int k = 0; k < 2; ++k) dst[n][k] = *(const PG8_LAS bf16x8*)(lds + PG8_SB(b, h) + boff + n * 2048 + k * 1024); } while (0)
#define PG8_MMA(ai, bj, At, Bt) do { __builtin_amdgcn_s_setprio(1); _Pragma("unroll") for (int m = 0; m < 4; ++m) _Pragma("unroll") for (int n = 0; n < 2; ++n) _Pragma("unroll") for (int k = 0; k < 2; ++k) \
        acc[ai][bj][m][n] = __builtin_amdgcn_mfma_f32_16x16x32_bf16(Bt[n][k], At[m][k], acc[ai][bj][m][n], 0, 0, 0); __builtin_amdgcn_s_setprio(0); } while (0)
#define PG8_WAIT_V(n) asm volatile("s_waitcnt vmcnt(" #n ")" ::: "memory")
#define PG8_WAIT_L(n) asm volatile("s_waitcnt lgkmcnt(" #n ")" ::: "memory")
#define PG8_BAR __builtin_amdgcn_s_barrier()
#define PG8_SCHED __builtin_amdgcn_sched_barrier(0)
    Unit cur, nxt; int ui = 0;
    if (!S.next(0, cur)) return;
    f32x4 acc[2][2][4][2];
#pragma unroll
    for (int a = 0; a < 2; ++a)
#pragma unroll
        for (int b = 0; b < 2; ++b)
#pragma unroll
            for (int m = 0; m < 4; ++m)
#pragma unroll
                for (int n = 0; n < 2; ++n) acc[a][b][m][n] = (f32x4){0.f, 0.f, 0.f, 0.f};
    bf16x8 At[4][2], B0[2][2], B1[2][2];
    const char* cA = (const char*)g.A + (size_t)cur.pm * tstep; const char* cB = (const char*)g.Bt + (size_t)cur.pn * tstep;
    S.a_ready(cur);
    PG8_STAGE(PG8_SB(0, 0), cB, voffB); PG8_STAGE(PG8_SA(0, 0), cA, voffA); PG8_STAGE(PG8_SB(0, 1), cB + hstep, voffB); PG8_STAGE(PG8_SA(0, 1), cA + hstep, voffA);
    if (wr == 1) PG8_BAR;
    PG8_WAIT_V(4); PG8_BAR;
    PG8_STAGE(PG8_SB(1, 0), cB + kstep, voffB); PG8_STAGE(PG8_SA(1, 0), cA + kstep, voffA); PG8_STAGE(PG8_SB(1, 1), cB + hstep + kstep, voffB);
    PG8_WAIT_V(6); PG8_BAR;
    PG8_STAMP();
    for (;;) {
        const bool has_next = S.next(ui + 1, nxt);
        const char* nA = has_next ? (const char*)g.A + (size_t)nxt.pm * tstep : cA; const char* nB = has_next ? (const char*)g.Bt + (size_t)nxt.pn * tstep : cB;
        for (int t = 0; t < nt; t += 2) {
            const bool last = (t == nt - 2);
            const char* a1 = cA + (size_t)(t + 1) * kstep;
            const char* a2 = last ? nA : cA + (size_t)(t + 2) * kstep; const char* b2 = last ? nB : cB + (size_t)(t + 2) * kstep;
            const char* a3 = a2 + kstep; const char* b3 = b2 + kstep;
            if (last && has_next) S.a_ready(nxt);
            PG8_LDB(B0, 0, 0); PG8_SCHED; PG8_LDA(At, 0, 0); PG8_STAGE(PG8_SA(1, 1), a1 + hstep, voffA);
            PG8_WAIT_L(8); PG8_BAR; PG8_WAIT_L(0); PG8_MMA(0, 0, At, B0); PG8_BAR; PG8_SCHED;
            PG8_LDB(B1, 0, 1); PG8_STAGE(PG8_SB(0, 0), b2, voffB);
            PG8_BAR; PG8_WAIT_L(0); PG8_MMA(0, 1, At, B1); PG8_BAR;
            PG8_LDA(At, 0, 1); PG8_STAGE(PG8_SA(0, 0), a2, voffA);
            PG8_BAR; PG8_WAIT_L(0); PG8_MMA(1, 0, At, B0); PG8_BAR; PG8_SCHED;
            PG8_STAGE(PG8_SB(0, 1), b2 + hstep, voffB);
            PG8_WAIT_V(6); PG8_BAR; PG8_MMA(1, 1, At, B1); PG8_BAR;
            PG8_LDB(B0, 1, 0); PG8_SCHED; PG8_LDA(At, 1, 0); PG8_STAGE(PG8_SA(0, 1), a2 + hstep, voffA);
            PG8_WAIT_L(8); PG8_BAR; PG8_WAIT_L(0); PG8_MMA(0, 0, At, B0); PG8_BAR; PG8_SCHED;
            PG8_LDB(B1, 1, 1); PG8_STAGE(PG8_SB(1, 0), b3, voffB);
            PG8_BAR; PG8_WAIT_L(0); PG8_MMA(0, 1, At, B1); PG8_BAR;
            PG8_LDA(At, 1, 1); PG8_STAGE(PG8_SA(1, 0), a3, voffA);
            PG8_BAR; PG8_WAIT_L(0); PG8_MMA(1, 0, At, B0); PG8_BAR; PG8_SCHED;
            PG8_STAGE(PG8_SB(1, 1), b3 + hstep, voffB);
            PG8_WAIT_V(6); PG8_BAR; PG8_MMA(1, 1, At, B1); PG8_BAR;
        }
        PG8_STAMP();
        if constexpr (!Epi::AFTER_DRAIN) { E(acc, cur, wr, wc, fr, fq); S.done(cur); }
        PG8_STAMP();
        if (!has_next) break;
#pragma unroll
        for (int a = 0; a < 2; ++a)
#pragma unroll
            for (int b = 0; b < 2; ++b)
#pragma unroll
                for (int m = 0; m < 4; ++m)
#pragma unroll
                    for (int n = 0; n < 2; ++n) acc[a][b][m][n] = (f32x4){0.f, 0.f, 0.f, 0.f};
        cur = nxt; cA = nA; cB = nB; ++ui;
    }
    PG8_WAIT_V(0);
    if (wr == 0) PG8_BAR;
    PG8_BAR;
    if constexpr (Epi::AFTER_DRAIN) { E.fused(acc, cur, wr, wc, fr, fq, lds, wid, lane); S.done(cur); }
    PG8_STAMP();
    if (STAMP && wid == 0) { stamps[lane] = lane < nts ? (((unsigned long long)(unsigned)ts_hi << 32) | (unsigned)ts_lo) : 0ull;
        if (lane == 62) stamps[62] = rt_entry; if (lane == 63) stamps[63] = (unsigned long long)wall_clock64(); }
#undef PG8_STAMP
#undef PG8_SA
#undef PG8_SB
#undef PG8_STAGE
#undef PG8_LDA
#undef PG8_LDB
#undef PG8_MMA
#undef PG8_WAIT_V
#undef PG8_WAIT_L
#undef PG8_BAR
#undef PG8_SCHED
}
}

namespace cg = cooperative_groups;
#define LAS __attribute__((address_space(3)))
typedef unsigned short bf16;
typedef short bf16x8 __attribute__((ext_vector_type(8)));
typedef float f32x4 __attribute__((ext_vector_type(4)));
typedef unsigned u32x4 __attribute__((ext_vector_type(4)));
typedef unsigned u32x2 __attribute__((ext_vector_type(2)));

constexpr int DM = 1024, NB = 8, SEQ = 8192, NTOK = NB * SEQ, CTXL = 256, NCTX = NB * CTXL, PROJW = 8192;
constexpr int NTHR = 512;
constexpr int LDS_BYTES = 160 * 1024;
constexpr float EPSF = 1e-6f;

constexpr size_t MiB = 1ull << 20, KiB = 1ull << 10;
constexpr size_t WS_WINT = 0, WS_WHYT = 16 * MiB, WS_WRETT = 18 * MiB, WS_WOT = 20 * MiB, WS_WQT = 22 * MiB;
constexpr size_t WS_KERN2 = 24 * MiB;
constexpr size_t WS_PU = 24 * MiB, WS_PV = 56 * MiB;
constexpr size_t WS_MISC = 88 * MiB;
constexpr size_t WS_MOD = WS_MISC, WS_ROT = WS_MISC + 256 * KiB, WS_GFEAT = WS_MISC + 512 * KiB, WS_KPART = WS_MISC + 3 * MiB,
                 WS_HCTX = WS_MISC + 5 * MiB, WS_CK = WS_MISC + 9 * MiB, WS_CV = WS_MISC + 11 * MiB;
constexpr size_t WS_A = 104 * MiB;
constexpr size_t WS_ZT = 232 * MiB;
constexpr size_t WS_X0T = 232 * MiB, WS_X1T = 360 * MiB, WS_VT = 488 * MiB;
constexpr size_t WS_QK = 616 * MiB, WS_V = 744 * MiB, WS_G = 872 * MiB, WS_END = 1000 * MiB;
constexpr size_t WS_OF = WS_X1T, WS_OB = WS_VT, WS_M = WS_QK, WS_H2 = WS_VT, WS_QP = WS_G, WS_RIDX = WS_X1T, WS_RGATE = WS_X1T + 32 * MiB;

struct Params {
    const float* in[31];
    float* out;
    unsigned char* ws;
};
enum { I_X = 0, I_C, I_CTX, I_CCTX, I_WADA, I_BADA, I_NORM1, I_NORM2, I_WIN, I_HCW, I_HCB, I_FW1, I_FB1, I_FW2, I_FB2, I_FW3, I_FB3, I_FW4, I_FREQ, I_DELTAS, I_HBIAS,
       I_LGF, I_LGB, I_WHY, I_WRET, I_WO, I_WQ, I_SUBK, I_PU, I_PV, I_FNORM };

__device__ __forceinline__ unsigned f2bf(float f) { unsigned u = __float_as_uint(f); return (u + 0x7fffu + ((u >> 16) & 1u)) >> 16; }
__device__ __forceinline__ unsigned pk2(float lo, float hi) { return f2bf(lo) | (f2bf(hi) << 16); }
__device__ __forceinline__ float bf_lo(unsigned w) { return __uint_as_float(w << 16); }
__device__ __forceinline__ float bf_hi(unsigned w) { return __uint_as_float(w & 0xffff0000u); }
__device__ __forceinline__ float bf1(bf16 h) { return __uint_as_float(((unsigned)h) << 16); }
__device__ __forceinline__ float wave_sum(float v) {
#pragma unroll
    for (int o = 1; o < 64; o <<= 1) v += __shfl_xor(v, o);
    return v;
}
__device__ __forceinline__ float sigmoidf_(float x) { return __builtin_amdgcn_rcpf(1.0f + __expf(-x)); }
__device__ __forceinline__ float rdlane(float v, int l) { return __int_as_float(__builtin_amdgcn_readlane(__float_as_int(v), l)); }


__device__ __forceinline__ void sincos_f(float x, float& s, float& c) {
    const float k = rintf(x * 0.636619772367581343f);
    const int qd = (int)k;
    float r = fmaf(-k, 1.57079625129699707031e+00f, x);
    r = fmaf(-k, 7.54978941586159635335e-08f, r);
    r = fmaf(-k, 5.39030295347424192935e-15f, r);
    const float r2 = r * r;
    const float sp = r + r * r2 * (-1.6666654611e-1f + r2 * (8.3321608736e-3f - r2 * 1.9515295891e-4f));
    const float cp = 1.0f - 0.5f * r2 + r2 * r2 * (4.166664568298827e-2f + r2 * (-1.388731625493765e-3f + r2 * 2.443315711809948e-5f));
    const float s1 = (qd & 1) ? cp : sp, c1 = (qd & 1) ? sp : cp;
    s = (qd & 2) ? -s1 : s1;
    c = ((qd + 1) & 2) ? -c1 : c1;
}
__device__ __forceinline__ float sin_f(float x) { float s, c; sincos_f(x, s, c); return s; }

__device__ __forceinline__ int win_dst_row(int n) {
    if (n >= 3072 && n < 4096) { const int e = n & 63; const int pp = (e < 32) ? (8 * (e >> 2) + (e & 3)) : (8 * ((e - 32) >> 2) + 4 + (e & 3)); return (n & ~63) + pp; }
    return n;
}
__device__ __forceinline__ void transpose_item(const float* __restrict__ W, int K, int N, bf16* __restrict__ WT, LAS float* scr, int item, int lane, bool permute) {
    const int nblk = N / 32, kb = item / nblk, nb = item % nblk, k0 = 64 * kb, n0 = 32 * nb;
#pragma unroll 8
    for (int i = 0; i < 32; ++i) { const int kk = 2 * i + (lane >> 5); scr[kk * 33 + (lane & 31)] = W[(size_t)(k0 + kk) * N + n0 + (lane & 31)]; }
    __builtin_amdgcn_s_waitcnt(0xC07F); asm volatile("" ::: "memory");
    const int c = lane & 7;
#pragma unroll
    for (int j = 0; j < 4; ++j) { const int n = (lane >> 3) + 8 * j; const LAS float* s = scr + (8 * c) * 33 + n;
        u32x4 o; o.x = pk2(s[0 * 33], s[1 * 33]); o.y = pk2(s[2 * 33], s[3 * 33]); o.z = pk2(s[4 * 33], s[5 * 33]); o.w = pk2(s[6 * 33], s[7 * 33]);
        const int nd = permute ? win_dst_row(n0 + n) : (n0 + n);
        *(u32x4*)(WT + (size_t)nd * K + k0 + 8 * c) = o; }
    __builtin_amdgcn_s_waitcnt(0xC07F); asm volatile("" ::: "memory");
}

__device__ __forceinline__ void ph0_prologue(const Params& p, unsigned char* smem) {
    const int tid = threadIdx.x, lane = tid & 63, wave = __builtin_amdgcn_readfirstlane(tid >> 6);
    const int gw = blockIdx.x * 8 + wave, NGW = gridDim.x * 8;
    unsigned char* ws = p.ws;
#ifndef P0M
#define P0M 15
#endif
#if P0M & 1
    {
        LAS float* st = (LAS float*)(LAS unsigned char*)smem;
        LAS float* red = (LAS float*)((LAS unsigned char*)smem + 36864);
        float* mod = (float*)(ws + WS_MOD);
        const float* wada = p.in[I_WADA];
        for (int item = blockIdx.x; item < 96; item += gridDim.x) {
            for (int i = tid; i < 9 * 1024; i += NTHR) { const int r = i >> 10, k = i & 1023; const float v = (r < 8) ? p.in[I_C][r * 1024 + k] : p.in[I_CCTX][k]; st[i] = v / (1.0f + __expf(-v)); }
            __syncthreads();
            const int j = item * 64 + lane;
            float acc[9];
#pragma unroll
            for (int r = 0; r < 9; ++r) acc[r] = 0.f;
            const int k0 = wave * 128;
#pragma unroll 4
            for (int k = k0; k < k0 + 128; ++k) { const float w = wada[(size_t)k * 6144 + j];
#pragma unroll
                for (int r = 0; r < 9; ++r) acc[r] += st[r * 1024 + k] * w; }
#pragma unroll
            for (int r = 0; r < 9; ++r) red[(wave * 9 + r) * 64 + lane] = acc[r];
            __syncthreads();
            for (int o = tid; o < 576; o += NTHR) { const int r = o >> 6, l = o & 63; float s = p.in[I_BADA][item * 64 + l];
#pragma unroll
                for (int w = 0; w < 8; ++w) s += red[(w * 9 + r) * 64 + l];
                mod[r * 6144 + item * 64 + l] = s; }
            __syncthreads();
        }
    }
#endif
#if P0M & 2
    {
        float2* rot = (float2*)(ws + WS_ROT);
        const int gt = blockIdx.x * NTHR + tid;
        if (gt < 4096) { const int pos = gt >> 5, f = gt & 31; const float inv = exp2f(-(float)f * (13.287712379549449f / 32.0f)); const float ang = (float)pos * inv; float sn, cs_; sincos_f(ang, sn, cs_); rot[gt] = make_float2(cs_, sn); }
    }
#endif
#if P0M & 4
    {
        const float *fw1 = p.in[I_FW1], *fb1 = p.in[I_FB1], *fw2 = p.in[I_FW2], *fb2 = p.in[I_FB2], *fw3 = p.in[I_FW3], *fb3 = p.in[I_FB3], *freq = p.in[I_FREQ];
        float* gfeat = (float*)(ws + WS_GFEAT);
        const float fq = freq[lane];
        LAS float* hb = (LAS float*)((LAS unsigned char*)smem + 65536 + wave * 1024);
        for (int t0 = gw * 4; t0 < SEQ; t0 += NGW * 4) {
            float a[4];
#pragma unroll
            for (int u = 0; u < 4; ++u) { const int t = t0 + u;
                const float tl = (float)t / 8191.0f;
                const float w = 7.66990393942820614859e-4f * (float)t;
                float zz = 0.f;
                if (lane == 0) zz = tl;
                else if (lane <= 16) { const float band = 1e-4f + (float)(lane - 1) * ((15.0f - 1e-4f) / 15.0f); float sn, cs_; sincos_f(band * w, sn, cs_); zz = cs_; }
                else if (lane <= 32) { const float band = 1e-4f + (float)(lane - 17) * ((15.0f - 1e-4f) / 15.0f); zz = -sin_f(band * w); }
                hb[u * 64 + lane] = zz; a[u] = fb1[lane]; }
            __builtin_amdgcn_s_waitcnt(0xC07F); asm volatile("" ::: "memory");
#pragma unroll 1
            for (int i = 0; i < 33; ++i) { const float wv = fw1[i * 64 + lane];
#pragma unroll
                for (int u = 0; u < 4; ++u) a[u] += hb[u * 64 + i] * wv; }
            asm volatile("" ::: "memory");
#pragma unroll
            for (int u = 0; u < 4; ++u) { hb[u * 64 + lane] = sin_f(fq * a[u]); a[u] = fb2[lane]; }
            __builtin_amdgcn_s_waitcnt(0xC07F); asm volatile("" ::: "memory");
#pragma unroll 1
            for (int i = 0; i < 64; ++i) { const float wv = fw2[i * 64 + lane];
#pragma unroll
                for (int u = 0; u < 4; ++u) a[u] += hb[u * 64 + i] * wv; }
            asm volatile("" ::: "memory");
#pragma unroll
            for (int u = 0; u < 4; ++u) { hb[u * 64 + lane] = sin_f(fq * a[u]); a[u] = fb3[lane]; }
            __builtin_amdgcn_s_waitcnt(0xC07F); asm volatile("" ::: "memory");
#pragma unroll 1
            for (int i = 0; i < 64; ++i) { const float wv = fw3[i * 64 + lane];
#pragma unroll
                for (int u = 0; u < 4; ++u) a[u] += hb[u * 64 + i] * wv; }
            asm volatile("" ::: "memory");
#pragma unroll
            for (int u = 0; u < 4; ++u) gfeat[(t0 + u) * 64 + lane] = sin_f(fq * a[u]);
        }
    }
#endif
#if P0M & 8
    __syncthreads();
    {
        LAS float* scr = (LAS float*)((LAS unsigned char*)smem + wave * 8448);
        constexpr int I_IN = 16 * 256, I_SQ = 16 * 32;
        constexpr int NITEMS = I_IN + 4 * I_SQ;
        for (int it = gw; it < NITEMS; it += NGW) {
            int r = it;
            if (r < I_IN) { transpose_item(p.in[I_WIN], 1024, 8192, (bf16*)(ws + WS_WINT), scr, r, lane, true); continue; } r -= I_IN;
            if (r < I_SQ) { transpose_item(p.in[I_WHY], 1024, 1024, (bf16*)(ws + WS_WHYT), scr, r, lane, false); continue; } r -= I_SQ;
            if (r < I_SQ) { transpose_item(p.in[I_WRET], 1024, 1024, (bf16*)(ws + WS_WRETT), scr, r, lane, false); continue; } r -= I_SQ;
            if (r < I_SQ) { transpose_item(p.in[I_WO], 1024, 1024, (bf16*)(ws + WS_WOT), scr, r, lane, false); continue; } r -= I_SQ;
            transpose_item(p.in[I_WQ], 1024, 1024, (bf16*)(ws + WS_WQT), scr, r, lane, false);
        }
    }
#endif
}

__device__ __forceinline__ void norm_mod_row(const float* xr, const float* gain, const float* shift, const float* scale, bf16* dst, int lane) {
    f32x4 v[4]; float ss = 0.f;
#pragma unroll
    for (int j = 0; j < 4; ++j) { v[j] = *(const f32x4*)(xr + 4 * lane + 256 * j); ss += (v[j].x * v[j].x + v[j].y * v[j].y) + (v[j].z * v[j].z + v[j].w * v[j].w); }
    ss = wave_sum(ss);
    const float rs = 1.0f / sqrtf(ss * (1.0f / 1024.0f) + EPSF);
#pragma unroll
    for (int j = 0; j < 4; ++j) { const int c0 = 4 * lane + 256 * j;
        const f32x4 n = *(const f32x4*)(gain + c0), sc = *(const f32x4*)(scale + c0), sh = *(const f32x4*)(shift + c0);
        const f32x4 y = v[j] * rs * n * (sc + 1.0f) + sh;
        u32x2 o; o.x = pk2(y.x, y.y); o.y = pk2(y.z, y.w);
        *(u32x2*)(dst + c0) = o; }
}

__device__ __forceinline__ void ph1_rows_and_taps(const Params& p, unsigned char* smem) {
    const int tid = threadIdx.x, lane = tid & 63, wave = __builtin_amdgcn_readfirstlane(tid >> 6);
    const int gw = blockIdx.x * 8 + wave, NGW = gridDim.x * 8;
    unsigned char* ws = p.ws;
    const float* mod = (const float*)(ws + WS_MOD);
    {
        LAS float* gs = (LAS float*)(LAS unsigned char*)smem;
        LAS float* w4s = (LAS float*)((LAS unsigned char*)smem + 16384);
        const float* gfeat = (const float*)(ws + WS_GFEAT);
        const float* fw4 = p.in[I_FW4];
        float* kern2 = (float*)(ws + WS_KERN2);
        float* kpart = (float*)(ws + WS_KPART);
        for (int un = blockIdx.x; un < 1024; un += gridDim.x) {
            const int tb = un >> 3, cb = un & 7;
            for (int i = tid; i < 1024; i += NTHR) ((LAS f32x4*)gs)[i] = ((const f32x4*)(gfeat + (size_t)tb * 4096))[i];
            for (int i = tid; i < 4096; i += NTHR) { const int j = i >> 6, c4 = i & 63; ((LAS f32x4*)w4s)[i] = *(const f32x4*)(fw4 + (size_t)j * 2048 + cb * 256 + c4 * 4); }
            __syncthreads();
            const int cl = tid & 255, th = tid >> 8;
            float acc[32];
#pragma unroll
            for (int tt = 0; tt < 32; ++tt) acc[tt] = 0.f;
            for (int j4 = 0; j4 < 16; ++j4) {
                const float w0 = w4s[(4 * j4 + 0) * 256 + cl], w1 = w4s[(4 * j4 + 1) * 256 + cl], w2 = w4s[(4 * j4 + 2) * 256 + cl], w3 = w4s[(4 * j4 + 3) * 256 + cl];
#pragma unroll
                for (int tt = 0; tt < 32; ++tt) { const f32x4 g4 = *(const LAS f32x4*)(gs + (32 * th + tt) * 64 + 4 * j4); acc[tt] += (g4.x * w0 + g4.y * w1) + (g4.z * w2 + g4.w * w3); }
            }
            const int cp = cb * 256 + cl, c = cp & 1023; const bool bwd = cp >= 1024;
            const float ad = fabsf(p.in[I_DELTAS][c]);
            float* krow = kern2 + (size_t)c * 16384;
            float part = 0.f;
#pragma unroll
            for (int tt = 0; tt < 32; ++tt) { const int t = 64 * tb + 32 * th + tt; const float tl = (float)t / 8191.0f; const float val = acc[tt] * expf(-tl * ad);
                if (!bwd) { krow[8192 + t] = val; part += fabsf(val); }
                else if (t > 0) { krow[8192 - t] = val; part += fabsf(val); }
                else krow[0] = 0.f; }
            kpart[(tb * 2 + th) * 2048 + cp] = part;
            __syncthreads();
        }
    }
    for (int r = gw; r < NTOK + NCTX; r += NGW) {
        const bool isc = r >= NTOK;
        const float* xr = isc ? p.in[I_CTX] + (size_t)(r - NTOK) * 1024 : p.in[I_X] + (size_t)r * 1024;
        const float* md = mod + (isc ? 8 : (r >> 13)) * 6144;
        bf16* dst = isc ? (bf16*)(ws + WS_HCTX) + (size_t)(r - NTOK) * 1024 : (bf16*)(ws + WS_A) + (size_t)r * 1024;
        norm_mod_row(xr, p.in[I_NORM1], md, md + 1024, dst, lane);
    }
}

struct EpiInProj {
    static constexpr bool PERM = true, AFTER_DRAIN = false;
    bf16* zT; bf16* QK; bf16* VG; bf16* AHR; const float2* rot;
    __device__ __forceinline__ void operator()(const pg8::f32x4 (&acc)[2][2][4][2], const pg8::Unit& u, int wr, int wc, int fr, int fq) const {
        const int pn = u.pn;
        const int row0 = u.pm * 256 + wr * 64 + fr;
        const int colw = wc * 32 + 8 * fq;
#ifndef EPM
#define EPM 7
#endif
        if ((EPM & 1) && pn < 12) {
            const int sec = pn >> 2, cbase = (pn & 3) * 256;
#pragma unroll
            for (int ai = 0; ai < 2; ++ai)
#pragma unroll
                for (int m = 0; m < 4; ++m) { const int row = row0 + ai * 128 + m * 16; const int b = row >> 13, t = row & 8191;
#pragma unroll
                    for (int bj = 0; bj < 2; ++bj) { const int c = cbase + bj * 128 + colw;
                        bf16* dst = zT + ((size_t)((sec * NB + b) * 1024 + c)) * SEQ + t;
#pragma unroll
                        for (int n = 0; n < 2; ++n)
#pragma unroll
                            for (int j = 0; j < 4; ++j) dst[(size_t)(4 * n + j) * SEQ] = (bf16)f2bf(acc[ai][bj][m][n][j]); }
                    asm volatile("" ::: "memory"); }
        } else if ((EPM & 2) && pn < 16) {
            const float scale = (pn >= 14) ? 0.08838834764831845f : 1.0f;
#pragma unroll
            for (int ai = 0; ai < 2; ++ai)
#pragma unroll
                for (int m = 0; m < 4; ++m) { const int row = row0 + ai * 128 + m * 16; const int t = row & 8191; const int prow = t >> 6, pcol = t & 63;
#pragma unroll
                    for (int bj = 0; bj < 2; ++bj) { const int cc = (pn - 12) * 256 + bj * 128 + colw;
                        const int half = (cc >> 6) & 1, g = (cc & 63) >> 3; const int pos = half ? pcol : prow;
                        const float2* rp = rot + pos * 32 + 4 * g;
                        float o1[4], o2[4];
#pragma unroll
                        for (int j = 0; j < 4; ++j) { const float2 cs = rp[j]; const float x1 = acc[ai][bj][m][0][j], x2 = acc[ai][bj][m][1][j];
                            o1[j] = (x1 * cs.x - x2 * cs.y) * scale; o2[j] = (x1 * cs.y + x2 * cs.x) * scale; }
                        bf16* dst = QK + (size_t)row * 1024 + (cc & ~63) + 4 * g;
                        u32x2 a, b2; a.x = pk2(o1[0], o1[1]); a.y = pk2(o1[2], o1[3]); b2.x = pk2(o2[0], o2[1]); b2.y = pk2(o2[2], o2[3]);
                        *(u32x2*)dst = a; *(u32x2*)(dst + 32) = b2; }
                    asm volatile("" ::: "memory"); }
        } else if (EPM & 4) {
            bf16* base = (pn < 24 ? VG : AHR) + (size_t)((pn >> 2) & 1) * ((size_t)NTOK * 1024);
            const int act = pn < 20 ? 0 : (pn < 24 ? 1 : 2);
#pragma unroll
            for (int ai = 0; ai < 2; ++ai)
#pragma unroll
                for (int m = 0; m < 4; ++m) { const int row = row0 + ai * 128 + m * 16;
#pragma unroll
                    for (int bj = 0; bj < 2; ++bj) { const int cc = (pn & 3) * 256 + bj * 128 + colw;
                        float v[8];
#pragma unroll
                        for (int n = 0; n < 2; ++n)
#pragma unroll
                            for (int j = 0; j < 4; ++j) { const float x = acc[ai][bj][m][n][j]; const float sg = sigmoidf_(x); v[4 * n + j] = act == 0 ? x : (act == 1 ? x * sg : sg); }
                        u32x4 w; w.x = pk2(v[0], v[1]); w.y = pk2(v[2], v[3]); w.z = pk2(v[4], v[5]); w.w = pk2(v[6], v[7]);
                        *(u32x4*)(base + (size_t)row * 1024 + cc) = w; }
                    asm volatile("" ::: "memory"); }
        }
    }
};
struct EpiCtx {
    static constexpr bool PERM = true, AFTER_DRAIN = false;
    bf16* CK; bf16* CV;
    __device__ __forceinline__ void operator()(const pg8::f32x4 (&acc)[2][2][4][2], const pg8::Unit& u, int wr, int wc, int fr, int fq) const {
        const int pn = u.pn;
        const int row0 = u.pm * 256 + wr * 64 + fr;
        const int colw = wc * 32 + 8 * fq;
#pragma unroll
        for (int ai = 0; ai < 2; ++ai)
#pragma unroll
            for (int m = 0; m < 4; ++m) { const int row = row0 + ai * 128 + m * 16;
#pragma unroll
                for (int bj = 0; bj < 2; ++bj) {
                    if (pn < 2) { const int cc = pn * 256 + bj * 128 + colw; const int g = (cc & 63) >> 3; const float scale = 0.08838834764831845f;
                        bf16* dst = CK + (size_t)row * 512 + (cc & ~63) + 4 * g;
                        u32x2 a, b2; a.x = pk2(acc[ai][bj][m][0][0] * scale, acc[ai][bj][m][0][1] * scale); a.y = pk2(acc[ai][bj][m][0][2] * scale, acc[ai][bj][m][0][3] * scale);
                        b2.x = pk2(acc[ai][bj][m][1][0] * scale, acc[ai][bj][m][1][1] * scale); b2.y = pk2(acc[ai][bj][m][1][2] * scale, acc[ai][bj][m][1][3] * scale);
                        *(u32x2*)dst = a; *(u32x2*)(dst + 32) = b2;
                    } else { const int cc = (pn - 2) * 256 + bj * 128 + colw;
                        u32x4 w; w.x = pk2(acc[ai][bj][m][0][0], acc[ai][bj][m][0][1]); w.y = pk2(acc[ai][bj][m][0][2], acc[ai][bj][m][0][3]);
                        w.z = pk2(acc[ai][bj][m][1][0], acc[ai][bj][m][1][1]); w.w = pk2(acc[ai][bj][m][1][2], acc[ai][bj][m][1][3]);
                        *(u32x4*)(CV + (size_t)row * 1024 + cc) = w; } } }
    }
};
template <int PASS> struct EpiMerge {
    static constexpr bool PERM = true, AFTER_DRAIN = false;
    bf16* Mo; const bf16* gate;
    __device__ __forceinline__ void operator()(const pg8::f32x4 (&acc)[2][2][4][2], const pg8::Unit& u, int wr, int wc, int fr, int fq) const {
        const int row0 = u.pm * 256 + wr * 64 + fr; const int col0 = u.pn * 256 + wc * 32 + 8 * fq;
#pragma unroll
        for (int ai = 0; ai < 2; ++ai)
#pragma unroll
            for (int m = 0; m < 4; ++m) { const size_t ro = (size_t)(row0 + ai * 128 + m * 16) * 1024 + col0;
#pragma unroll
                for (int bj = 0; bj < 2; ++bj) { const u32x4 gw = *(const u32x4*)(gate + ro + bj * 128);
                    float v[8];
                    v[0] = acc[ai][bj][m][0][0] * bf_lo(gw.x); v[1] = acc[ai][bj][m][0][1] * bf_hi(gw.x); v[2] = acc[ai][bj][m][0][2] * bf_lo(gw.y); v[3] = acc[ai][bj][m][0][3] * bf_hi(gw.y);
                    v[4] = acc[ai][bj][m][1][0] * bf_lo(gw.z); v[5] = acc[ai][bj][m][1][1] * bf_hi(gw.z); v[6] = acc[ai][bj][m][1][2] * bf_lo(gw.w); v[7] = acc[ai][bj][m][1][3] * bf_hi(gw.w);
                    if (PASS == 1) { const u32x4 pw = *(const u32x4*)(Mo + ro + bj * 128);
                        v[0] += bf_lo(pw.x); v[1] += bf_hi(pw.x); v[2] += bf_lo(pw.y); v[3] += bf_hi(pw.y); v[4] += bf_lo(pw.z); v[5] += bf_hi(pw.z); v[6] += bf_lo(pw.w); v[7] += bf_hi(pw.w); }
                    u32x4 w; w.x = pk2(v[0], v[1]); w.y = pk2(v[2], v[3]); w.z = pk2(v[4], v[5]); w.w = pk2(v[6], v[7]);
                    *(u32x4*)(Mo + ro + bj * 128) = w; } }
    }
};
struct EpiResid {
    static constexpr bool PERM = false, AFTER_DRAIN = false;
    const float* x; float* out; const float* mod;
    __device__ __forceinline__ void operator()(const pg8::f32x4 (&acc)[2][2][4][2], const pg8::Unit& u, int wr, int wc, int fr, int fq) const {
        const int row0 = u.pm * 256 + wr * 64 + fr, col0 = u.pn * 256 + wc * 32 + 4 * fq;
        const int b = (u.pm * 256) >> 13;
        f32x4 gv[2][2];
#pragma unroll
        for (int bj = 0; bj < 2; ++bj)
#pragma unroll
            for (int n = 0; n < 2; ++n) gv[bj][n] = *(const f32x4*)(mod + b * 6144 + 2048 + col0 + bj * 128 + n * 16);
#pragma unroll
        for (int ai = 0; ai < 2; ++ai)
#pragma unroll
            for (int m = 0; m < 4; ++m) { const size_t ro = (size_t)(row0 + ai * 128 + m * 16) * 1024 + col0;
#pragma unroll
                for (int bj = 0; bj < 2; ++bj)
#pragma unroll
                    for (int n = 0; n < 2; ++n) { const f32x4 xv = *(const f32x4*)(x + ro + bj * 128 + n * 16);
                        *(f32x4*)(out + ro + bj * 128 + n * 16) = xv + gv[bj][n] * acc[ai][bj][m][n]; } }
    }
};

__device__ __forceinline__ void conv3_row16(const bf16* row, int tid, float w0, float w1, float w2, float bias, float (&o)[16]) {
    const bf16* px = row + 16 * tid;
    const u32x4 A0 = *(const u32x4*)px, A1 = *(const u32x4*)(px + 8);
    float e[18];
    e[0] = tid > 0 ? bf1(px[-1]) : 0.f; e[17] = tid < 511 ? bf1(px[16]) : 0.f;
    e[1] = bf_lo(A0.x); e[2] = bf_hi(A0.x); e[3] = bf_lo(A0.y); e[4] = bf_hi(A0.y); e[5] = bf_lo(A0.z); e[6] = bf_hi(A0.z); e[7] = bf_lo(A0.w); e[8] = bf_hi(A0.w);
    e[9] = bf_lo(A1.x); e[10] = bf_hi(A1.x); e[11] = bf_lo(A1.y); e[12] = bf_hi(A1.y); e[13] = bf_lo(A1.z); e[14] = bf_hi(A1.z); e[15] = bf_lo(A1.w); e[16] = bf_hi(A1.w);
#pragma unroll
    for (int a = 0; a < 16; ++a) o[a] = (w0 * e[a] + w1 * e[a + 1]) + (w2 * e[a + 2] + bias);
}
__device__ __forceinline__ void ph3_hyena_conv(const Params& p, unsigned char* smem) {
    const int tid = threadIdx.x, lane = tid & 63, wave = __builtin_amdgcn_readfirstlane(tid >> 6);
    unsigned char* ws = p.ws;
    LAS float* us = (LAS float*)(LAS unsigned char*)smem;
    LAS float* ks = (LAS float*)((LAS unsigned char*)smem + 32768);
    LAS float* red = (LAS float*)((LAS unsigned char*)smem + 98304);
    const float* kern2 = (const float*)(ws + WS_KERN2);
    const float* kpart = (const float*)(ws + WS_KPART);
    bf16* zT = (bf16*)(ws + WS_ZT);
    const float* cw = p.in[I_HCW]; const float* cb = p.in[I_HCB];
    for (int c = blockIdx.x; c < 1024; c += gridDim.x) {
        __syncthreads();
        for (int i = tid; i < 4096; i += NTHR) ((LAS f32x4*)ks)[i] = ((const f32x4*)(kern2 + (size_t)c * 16384))[i];
        float pv = kpart[(tid >> 1) * 2048 + (tid & 1) * 1024 + c];
        pv = wave_sum(pv);
        if (lane == 0) red[wave] = pv;
        __syncthreads();
        float tot = 0.f;
#pragma unroll
        for (int w = 0; w < 8; ++w) tot += red[w];
        const float inv = 1.0f / (tot + EPSF);
        const float x0w0 = cw[c], x0w1 = cw[3072 + c], x0w2 = cw[6144 + c], x0b = cb[c];
        const float x1w0 = cw[1024 + c], x1w1 = cw[3072 + 1024 + c], x1w2 = cw[6144 + 1024 + c], x1b = cb[1024 + c];
        const float vw0 = cw[2048 + c], vw1 = cw[3072 + 2048 + c], vw2 = cw[6144 + 2048 + c], vb = cb[2048 + c];
        const float skip = p.in[I_HBIAS][c];
        for (int b = 0; b < NB; ++b) {
            bf16* x0r = zT + ((size_t)((0 * NB + b) * 1024 + c)) * SEQ;
            const bf16* x1r = zT + ((size_t)((1 * NB + b) * 1024 + c)) * SEQ;
            const bf16* vr = zT + ((size_t)((2 * NB + b) * 1024 + c)) * SEQ;
            float u[16];
            { float a1[16], a2[16]; conv3_row16(x1r, tid, x1w0, x1w1, x1w2, x1b, a1); conv3_row16(vr, tid, vw0, vw1, vw2, vb, a2);
#pragma unroll
              for (int a = 0; a < 16; ++a) u[a] = a1[a] * a2[a]; }
#pragma unroll
            for (int a4 = 0; a4 < 4; ++a4) ((LAS f32x4*)us)[4 * tid + a4] = (f32x4){u[4 * a4], u[4 * a4 + 1], u[4 * a4 + 2], u[4 * a4 + 3]};
            __syncthreads();
            float acc[16];
#pragma unroll
            for (int a = 0; a < 16; ++a) acc[a] = 0.f;
            float w[32];
            { const int base = 16 * tid + 8192;
#pragma unroll
              for (int a4 = 0; a4 < 4; ++a4) { const f32x4 k4 = *(const LAS f32x4*)(ks + base + 4 * a4); w[16 + 4 * a4] = k4.x; w[17 + 4 * a4] = k4.y; w[18 + 4 * a4] = k4.z; w[19 + 4 * a4] = k4.w; } }
#pragma unroll 2
            for (int s0 = 0; s0 < SEQ; s0 += 16) {
                const int base = 16 * tid + 8192 - s0;
                float uu[16];
#pragma unroll
                for (int a4 = 0; a4 < 4; ++a4) { const f32x4 k4 = *(const LAS f32x4*)(ks + base - 16 + 4 * a4); w[4 * a4] = k4.x; w[4 * a4 + 1] = k4.y; w[4 * a4 + 2] = k4.z; w[4 * a4 + 3] = k4.w;
                    const f32x4 u4 = *(const LAS f32x4*)(us + s0 + 4 * a4); uu[4 * a4] = u4.x; uu[4 * a4 + 1] = u4.y; uu[4 * a4 + 2] = u4.z; uu[4 * a4 + 3] = u4.w; }
#pragma unroll
                for (int bq = 0; bq < 16; ++bq)
#pragma unroll
                    for (int a = 0; a < 16; ++a) acc[a] += uu[bq] * w[a - bq + 16];
#pragma unroll
                for (int a = 0; a < 16; ++a) w[16 + a] = w[a];
            }
            float x0c[16];
            conv3_row16(x0r, tid, x0w0, x0w1, x0w2, x0b, x0c);
            float o[16];
#pragma unroll
            for (int a = 0; a < 16; ++a) o[a] = (acc[a] * inv + u[a] * skip) * x0c[a];
            __syncthreads();
            u32x4 o0, o1; o0.x = pk2(o[0], o[1]); o0.y = pk2(o[2], o[3]); o0.z = pk2(o[4], o[5]); o0.w = pk2(o[6], o[7]);
            o1.x = pk2(o[8], o[9]); o1.y = pk2(o[10], o[11]); o1.z = pk2(o[12], o[13]); o1.w = pk2(o[14], o[15]);
            *(u32x4*)(x0r + 16 * tid) = o0; *(u32x4*)(x0r + 16 * tid + 8) = o1;
        }
    }
}

__device__ __forceinline__ bf16x8 mk8(unsigned a, unsigned b, unsigned c, unsigned d) { u32x4 t = {a, b, c, d}; return __builtin_bit_cast(bf16x8, t); }
__device__ __forceinline__ void ph4_retention(const Params& p, unsigned char* smem) {
    constexpr int PK = 136;
    const int tid = threadIdx.x, lane = tid & 63, w = __builtin_amdgcn_readfirstlane(tid >> 6), r16 = lane & 15, q = lane >> 4;
    unsigned char* ws = p.ws;
    LAS unsigned char* lds = (LAS unsigned char*)smem;
    LAS bf16* Ks = (LAS bf16*)lds;
    LAS bf16* KTs = (LAS bf16*)(lds + 34816);
    LAS bf16* VTs = (LAS bf16*)(lds + 69632);
    LAS bf16* STs = (LAS bf16*)(lds + 87040);
    const bf16* QKb = (const bf16*)(ws + WS_QK); const bf16* Vb = (const bf16*)(ws + WS_V);
    const bf16* CKb = (const bf16*)(ws + WS_CK); const bf16* CVb = (const bf16*)(ws + WS_CV);
    for (int un = blockIdx.x; un < 256; un += gridDim.x) {
        const int b = un >> 5, h = (un >> 3) & 3, dir = (un >> 2) & 1, vs = un & 3;
        const float lg2 = (dir ? p.in[I_LGB] : p.in[I_LGF])[h] * 1.4426950408889634f;
        const float gC = exp2f(lg2 * 128.0f);
        bf16* Odst = (bf16*)(ws + (dir ? WS_OB : WS_OF));
        const int kj = tid >> 4, kcq = tid & 15;
        const int vj = tid >> 3, vcq = tid & 7;
        float zeta[4];
#pragma unroll
        for (int k = 0; k < 4; ++k) { const int j = kj + 32 * k; zeta[k] = exp2f(lg2 * (float)(dir ? j : 127 - j)); }
        float xi[4];
#pragma unroll
        for (int r = 0; r < 4; ++r) { const int i = 16 * w + 4 * q + r; xi[r] = exp2f(lg2 * (float)((dir ? 127 - i : i) + 1)); }
        const float sgf = dir ? -1.0f : 1.0f;
        int tr[4]; float pr[4];
        { int il = 16 * w + r16; asm volatile("" : "+v"(il));
#pragma unroll
          for (int r = 0; r < 4; ++r) { tr[r] = il - 4 * q - r; pr[r] = exp2f(lg2 * sgf * (float)tr[r]); } }
        float scs[8];
#pragma unroll
        for (int e = 0; e < 8; ++e) scs[e] = __int_as_float(__builtin_amdgcn_readfirstlane(__float_as_int(exp2f(-lg2 * sgf * (float)(16 * e)))));
        f32x4 Sacc[4];
#pragma unroll
        for (int vt = 0; vt < 4; ++vt) Sacc[vt] = (f32x4){0.f, 0.f, 0.f, 0.f};
        u32x4 kreg[4], vreg[2]; bf16x8 qf[4];
#pragma unroll
        for (int k = 0; k < 4; ++k) qf[k] = mk8(0, 0, 0, 0);
#define RET_LOAD(st_) do { const int s_ = (st_); \
            if (s_ < 2) { const int ci = dir ? 1 - s_ : s_; const size_t tok0 = (size_t)b * 256 + ci * 128; \
                const bf16* Kp = CKb + tok0 * 512 + h * 128; const bf16* Vp = CVb + tok0 * 1024 + h * 256 + vs * 64; \
                _Pragma("unroll") for (int k = 0; k < 4; ++k) kreg[k] = *(const u32x4*)(Kp + (size_t)(kj + 32 * k) * 512 + 8 * kcq); \
                _Pragma("unroll") for (int k = 0; k < 2; ++k) vreg[k] = *(const u32x4*)(Vp + (size_t)(vj + 64 * k) * 1024 + 8 * vcq); \
            } else { const int n = dir ? 63 - (s_ - 2) : s_ - 2; const size_t tok0 = (size_t)b * SEQ + n * 128; \
                const bf16* Kp = QKb + tok0 * 1024 + 512 + h * 128; const bf16* Vp = Vb + tok0 * 1024 + h * 256 + vs * 64; \
                _Pragma("unroll") for (int k = 0; k < 4; ++k) kreg[k] = *(const u32x4*)(Kp + (size_t)(kj + 32 * k) * 1024 + 8 * kcq); \
                _Pragma("unroll") for (int k = 0; k < 2; ++k) vreg[k] = *(const u32x4*)(Vp + (size_t)(vj + 64 * k) * 1024 + 8 * vcq); \
            } } while (0)
        RET_LOAD(0);
        for (int st = 0; st < 66; ++st) {
            if (st >= 2) { const int n = dir ? 63 - (st - 2) : st - 2; const bf16* Qp = QKb + ((size_t)b * SEQ + n * 128) * 1024 + h * 128;
#pragma unroll
                for (int k = 0; k < 4; ++k) qf[k] = *(const bf16x8*)(Qp + (size_t)(16 * w + r16) * 1024 + 32 * k + 8 * q); }
            __syncthreads();
#pragma unroll
            for (int k = 0; k < 4; ++k) { const int j = kj + 32 * k; *(LAS u32x4*)(Ks + j * PK + 8 * kcq) = kreg[k];
                const unsigned wv[4] = {kreg[k].x, kreg[k].y, kreg[k].z, kreg[k].w};
#pragma unroll
                for (int e2 = 0; e2 < 4; ++e2) { KTs[(8 * kcq + 2 * e2) * PK + j] = (bf16)f2bf(bf_lo(wv[e2]) * zeta[k]); KTs[(8 * kcq + 2 * e2 + 1) * PK + j] = (bf16)f2bf(bf_hi(wv[e2]) * zeta[k]); } }
#pragma unroll
            for (int k = 0; k < 2; ++k) { const int j = vj + 64 * k; const unsigned wv[4] = {vreg[k].x, vreg[k].y, vreg[k].z, vreg[k].w};
#pragma unroll
                for (int e2 = 0; e2 < 4; ++e2) { VTs[(8 * vcq + 2 * e2) * PK + j] = (bf16)(wv[e2] & 0xffffu); VTs[(8 * vcq + 2 * e2 + 1) * PK + j] = (bf16)(wv[e2] >> 16); } }
#pragma unroll
            for (int vt = 0; vt < 4; ++vt) { u32x2 sv; sv.x = pk2(Sacc[vt][0], Sacc[vt][1]); sv.y = pk2(Sacc[vt][2], Sacc[vt][3]); *(LAS u32x2*)(STs + (16 * vt + r16) * PK + 16 * w + 4 * q) = sv; }
            __syncthreads();
            if (st + 1 < 66) RET_LOAD(st + 1);
            if (st >= 2) {
                const int n = dir ? 63 - (st - 2) : st - 2; const size_t tok0 = (size_t)b * SEQ + n * 128;
                bf16x8 Pf[4];
#pragma unroll
                for (int ks_ = 0; ks_ < 4; ++ks_) {
                    f32x4 Xa = (f32x4){0.f, 0.f, 0.f, 0.f}, Xb = (f32x4){0.f, 0.f, 0.f, 0.f};
#pragma unroll
                    for (int kd = 0; kd < 4; ++kd) { const bf16x8 A0 = *(const LAS bf16x8*)(Ks + (32 * ks_ + r16) * PK + 32 * kd + 8 * q), A1 = *(const LAS bf16x8*)(Ks + (32 * ks_ + 16 + r16) * PK + 32 * kd + 8 * q);
                        Xa = __builtin_amdgcn_mfma_f32_16x16x32_bf16(A0, qf[kd], Xa, 0, 0, 0); Xb = __builtin_amdgcn_mfma_f32_16x16x32_bf16(A1, qf[kd], Xb, 0, 0, 0); }
                    float pv[8];
#pragma unroll
                    for (int r = 0; r < 4; ++r) { const int da = tr[r] - 32 * ks_, db = da - 16; const bool oka = dir ? (da <= 0) : (da >= 0), okb = dir ? (db <= 0) : (db >= 0);
                        pv[r] = oka ? Xa[r] * (pr[r] * scs[2 * ks_]) : 0.f; pv[4 + r] = okb ? Xb[r] * (pr[r] * scs[2 * ks_ + 1]) : 0.f; }
                    Pf[ks_] = mk8(pk2(pv[0], pv[1]), pk2(pv[2], pv[3]), pk2(pv[4], pv[5]), pk2(pv[6], pv[7]));
                    __builtin_amdgcn_sched_barrier(0);
                }
#pragma unroll
                for (int vt = 0; vt < 4; ++vt) { f32x4 O = (f32x4){0.f, 0.f, 0.f, 0.f};
#pragma unroll
                    for (int ks_ = 0; ks_ < 4; ++ks_) { const bf16x8 Bq = *(const LAS bf16x8*)(STs + (16 * vt + r16) * PK + 32 * ks_ + 8 * q); O = __builtin_amdgcn_mfma_f32_16x16x32_bf16(qf[ks_], Bq, O, 0, 0, 0); }
#pragma unroll
                    for (int r = 0; r < 4; ++r) O[r] *= xi[r];
#pragma unroll
                    for (int ks_ = 0; ks_ < 4; ++ks_) { const u32x2 lo = *(const LAS u32x2*)(VTs + (16 * vt + r16) * PK + 32 * ks_ + 4 * q), hi = *(const LAS u32x2*)(VTs + (16 * vt + r16) * PK + 32 * ks_ + 16 + 4 * q);
                        O = __builtin_amdgcn_mfma_f32_16x16x32_bf16(Pf[ks_], mk8(lo.x, lo.y, hi.x, hi.y), O, 0, 0, 0); }
                    bf16* od = Odst + (tok0 + 16 * w + 4 * q) * 1024 + h * 256 + vs * 64 + 16 * vt + r16;
#pragma unroll
                    for (int r = 0; r < 4; ++r) od[r * 1024] = (bf16)f2bf(O[r]);
                    __builtin_amdgcn_sched_barrier(0);
                }
            }
#pragma unroll
            for (int vt = 0; vt < 4; ++vt) { Sacc[vt] = Sacc[vt] * gC;
#pragma unroll
                for (int ks_ = 0; ks_ < 4; ++ks_) { const bf16x8 A = *(const LAS bf16x8*)(KTs + (16 * w + r16) * PK + 32 * ks_ + 8 * q), Bv = *(const LAS bf16x8*)(VTs + (16 * vt + r16) * PK + 32 * ks_ + 8 * q);
                    Sacc[vt] = __builtin_amdgcn_mfma_f32_16x16x32_bf16(A, Bv, Sacc[vt], 0, 0, 0); }
                __builtin_amdgcn_sched_barrier(0); }
        }
#undef RET_LOAD
    }
    __syncthreads();
}
__device__ __forceinline__ void ph4_transpose_yh(const Params& p, unsigned char* smem) {
    const int tid = threadIdx.x, lane = tid & 63, wave = __builtin_amdgcn_readfirstlane(tid >> 6);
    const int gw = blockIdx.x * 8 + wave, NGW = gridDim.x * 8;
    LAS bf16* tile = (LAS bf16*)((LAS unsigned char*)smem + wave * 8448);
    const bf16* yhT = (const bf16*)(p.ws + WS_X0T); bf16* yh = (bf16*)(p.ws + WS_A);
    for (int it = gw; it < 16384; it += NGW) {
        const int b = it >> 11, cb = (it >> 7) & 15, tb = it & 127;
        const bf16* src = yhT + ((size_t)(b * 1024 + cb * 64)) * SEQ + tb * 64;
#pragma unroll
        for (int k = 0; k < 8; ++k) { const int pc = lane + 64 * k, row = pc >> 3, ch = pc & 7; const u32x4 v = *(const u32x4*)(src + (size_t)row * SEQ + 8 * ch);
            const unsigned wv[4] = {v.x, v.y, v.z, v.w};
#pragma unroll
            for (int e2 = 0; e2 < 4; ++e2) { tile[(8 * ch + 2 * e2) * 66 + row] = (bf16)(wv[e2] & 0xffffu); tile[(8 * ch + 2 * e2 + 1) * 66 + row] = (bf16)(wv[e2] >> 16); } }
        __builtin_amdgcn_s_waitcnt(0xC07F); asm volatile("" ::: "memory");
        bf16* dst = yh + ((size_t)(b * SEQ + tb * 64)) * 1024 + cb * 64;
#pragma unroll
        for (int k = 0; k < 32; ++k) { const int idx = lane + 64 * k, trow = idx >> 5, cw = idx & 31; const unsigned wd = *(const LAS unsigned*)(tile + trow * 66 + 2 * cw);
            *(unsigned*)(dst + (size_t)trow * 1024 + 2 * cw) = wd; }
        __builtin_amdgcn_s_waitcnt(0xC07F); asm volatile("" ::: "memory");
    }
}

__device__ __forceinline__ void ph5_readout(const Params& p) {
    const int tid = threadIdx.x, lane = tid & 63, wave = __builtin_amdgcn_readfirstlane(tid >> 6);
    const int gw = blockIdx.x * 8 + wave, NGW = gridDim.x * 8;
    bf16* OF = (bf16*)(p.ws + WS_OF); const bf16* OB = (const bf16*)(p.ws + WS_OB); const bf16* G = (const bf16*)(p.ws + WS_G);
    for (int it = gw; it < NTOK * 4; it += NGW) {
        const size_t off = (size_t)it * 256 + 4 * lane;
        const u32x2 a = *(const u32x2*)(OF + off), b = *(const u32x2*)(OB + off), g = *(const u32x2*)(G + off);
        float o[4] = {bf_lo(a.x) + bf_lo(b.x), bf_hi(a.x) + bf_hi(b.x), bf_lo(a.y) + bf_lo(b.y), bf_hi(a.y) + bf_hi(b.y)};
        float ss = (o[0] * o[0] + o[1] * o[1]) + (o[2] * o[2] + o[3] * o[3]);
        ss = wave_sum(ss);
        const float rs = 1.0f / sqrtf(ss * (1.0f / 256.0f) + EPSF);
        u32x2 r; r.x = pk2(o[0] * rs * bf_lo(g.x), o[1] * rs * bf_hi(g.x)); r.y = pk2(o[2] * rs * bf_lo(g.y), o[3] * rs * bf_hi(g.y));
        *(u32x2*)(OF + off) = r;
    }
    const size_t gt = (size_t)blockIdx.x * NTHR + tid, NGT = (size_t)gridDim.x * NTHR;
    for (size_t i = gt; i < (size_t)2 * 16384 * 1024 / 8; i += NGT) {
        const size_t tsel = i >> 21, j = i & ((1u << 21) - 1);
        const float* src = (tsel ? p.in[I_PV] : p.in[I_PU]) + j * 8; bf16* dst = (bf16*)(p.ws + (tsel ? WS_PV : WS_PU)) + j * 8;
        const f32x4 a = *(const f32x4*)src, b = *(const f32x4*)(src + 4);
        u32x4 o; o.x = pk2(a.x, a.y); o.y = pk2(a.z, a.w); o.z = pk2(b.x, b.y); o.w = pk2(b.z, b.w);
        *(u32x4*)dst = o;
    }
}

__device__ __forceinline__ void ph8_rows2(const Params& p) {
    const int tid = threadIdx.x, lane = tid & 63, wave = __builtin_amdgcn_readfirstlane(tid >> 6);
    const int gw = blockIdx.x * 8 + wave, NGW = gridDim.x * 8;
    const float* mod = (const float*)(p.ws + WS_MOD);
    for (int r = gw; r < NTOK; r += NGW) { const float* md = mod + (r >> 13) * 6144;
        norm_mod_row(p.out + (size_t)r * 1024, p.in[I_NORM2], md + 3072, md + 4096, (bf16*)(p.ws + WS_H2) + (size_t)r * 1024, lane); }
}

__device__ __forceinline__ int f2sort(float f) { const int b = __float_as_int(f); return b ^ ((b >> 31) & 0x7fffffff); }
__device__ __forceinline__ float sort2f(int k) { return __int_as_float(k ^ ((k >> 31) & 0x7fffffff)); }
__device__ __forceinline__ void ph10_route(const Params& p) {
    const int tid = threadIdx.x, lane = tid & 63, h = __builtin_amdgcn_readfirstlane(tid >> 6);
    const bf16* QP = (const bf16*)(p.ws + WS_QP);
    int* ridx = (int*)(p.ws + WS_RIDX); float* rgate = (float*)(p.ws + WS_RGATE);
    const float* subk = p.in[I_SUBK];
    for (int tg = blockIdx.x; tg < NTOK / 64; tg += gridDim.x) {
        const int tok = tg * 64 + lane;
        int l1[16], l2[16];
#pragma unroll
        for (int c = 0; c < 2; ++c) {
            const bf16* qp = QP + (size_t)tok * 1024 + h * 128 + c * 64;
            float qv[64];
#pragma unroll
            for (int k = 0; k < 8; ++k) { const u32x4 v = *(const u32x4*)(qp + 8 * k);
                qv[8 * k] = bf_lo(v.x); qv[8 * k + 1] = bf_hi(v.x); qv[8 * k + 2] = bf_lo(v.y); qv[8 * k + 3] = bf_hi(v.y); qv[8 * k + 4] = bf_lo(v.z); qv[8 * k + 5] = bf_hi(v.z); qv[8 * k + 6] = bf_lo(v.w); qv[8 * k + 7] = bf_hi(v.w); }
            const float* kp = subk + (size_t)(h * 2 + c) * 128 * 64;
            int lst[16];
#pragma unroll
            for (int k = 0; k < 16; ++k) lst[k] = (int)0x80000000;
            for (int n = 0; n < 128; ++n) {
                const float* kr = kp + n * 64;
                float s0 = 0.f, s1 = 0.f;
#pragma unroll
                for (int d = 0; d < 64; d += 2) { s0 += qv[d] * kr[d]; s1 += qv[d + 1] * kr[d + 1]; }
                int key = (f2sort(s0 + s1) & ~127) | (127 - n);
#pragma unroll
                for (int k = 0; k < 16; ++k) { const int mx = max(lst[k], key); key = min(lst[k], key); lst[k] = mx; }
            }
#pragma unroll
            for (int k = 0; k < 16; ++k) { if (c == 0) l1[k] = lst[k]; else l2[k] = lst[k]; }
        }
        float cs[16]; int cp[16];
#pragma unroll
        for (int k = 0; k < 16; ++k) { cs[k] = -3.0e38f; cp[k] = 0; }
#pragma unroll
        for (int a = 0; a < 16; ++a)
#pragma unroll
            for (int bq = 0; bq < 16; ++bq) if ((a + 1) * (bq + 1) <= 16) {
                float v = sort2f(l1[a] & ~127) + sort2f(l2[bq] & ~127);
                int pay = ((127 - (l1[a] & 127)) << 7) | (127 - (l2[bq] & 127));
#pragma unroll
                for (int k = 0; k < 16; ++k) { const bool gt = v > cs[k]; const float tv = gt ? cs[k] : v; const int tp = gt ? cp[k] : pay; cs[k] = gt ? v : cs[k]; cp[k] = gt ? pay : cp[k]; v = tv; pay = tp; }
            }
        float e[16], sum = 0.f;
#pragma unroll
        for (int k = 0; k < 16; ++k) { e[k] = __expf(cs[k] - cs[0]); sum += e[k]; }
        const float rinv = 1.0f / sum;
        const size_t ro = ((size_t)tok * 8 + h) * 16;
#pragma unroll
        for (int k4 = 0; k4 < 4; ++k4) { *(int4*)(ridx + ro + 4 * k4) = make_int4(cp[4 * k4], cp[4 * k4 + 1], cp[4 * k4 + 2], cp[4 * k4 + 3]);
            *(f32x4*)(rgate + ro + 4 * k4) = (f32x4){e[4 * k4] * rinv, e[4 * k4 + 1] * rinv, e[4 * k4 + 2] * rinv, e[4 * k4 + 3] * rinv}; }
    }
}

__device__ __forceinline__ float gelu_tanh(float x) { const float z = 0.7978845608028654f * (x + 0.044715f * x * x * x); const float t = 1.0f - 2.0f / (__expf(2.0f * z) + 1.0f); return 0.5f * x * (1.0f + t); }
__device__ __forceinline__ void unpack8(const u32x4 v, float (&o)[8]) { o[0] = bf_lo(v.x); o[1] = bf_hi(v.x); o[2] = bf_lo(v.y); o[3] = bf_hi(v.y); o[4] = bf_lo(v.z); o[5] = bf_hi(v.z); o[6] = bf_lo(v.w); o[7] = bf_hi(v.w); }
__device__ __forceinline__ void ph11_experts(const Params& p) {
    const int tid = threadIdx.x, lane = tid & 63, wave = __builtin_amdgcn_readfirstlane(tid >> 6);
    const int gw = blockIdx.x * 8 + wave, NGW = gridDim.x * 8;
    const bf16* H2 = (const bf16*)(p.ws + WS_H2); const bf16* PU = (const bf16*)(p.ws + WS_PU); const bf16* PVt = (const bf16*)(p.ws + WS_PV);
    const int* ridx = (const int*)(p.ws + WS_RIDX); const float* rgate = (const float*)(p.ws + WS_RGATE);
    const float* mod = (const float*)(p.ws + WS_MOD);
    for (int tok = gw; tok < NTOK; tok += NGW) {
        float xf[16];
        { const u32x4 a = *(const u32x4*)(H2 + (size_t)tok * 1024 + 8 * lane), b = *(const u32x4*)(H2 + (size_t)tok * 1024 + 512 + 8 * lane);
          float t0[8], t1[8]; unpack8(a, t0); unpack8(b, t1);
#pragma unroll
          for (int k = 0; k < 8; ++k) { xf[k] = t0[k]; xf[8 + k] = t1[k]; } }
        const int id0 = ridx[(size_t)tok * 128 + lane], id1 = ridx[(size_t)tok * 128 + 64 + lane];
        const float g0 = rgate[(size_t)tok * 128 + lane], g1 = rgate[(size_t)tok * 128 + 64 + lane];
        float out[16];
#pragma unroll
        for (int k = 0; k < 16; ++k) out[k] = 0.f;
#pragma unroll 1
        for (int half = 0; half < 2; ++half) {
            const int idv = half ? id1 : id0; const float gv = half ? g1 : g0;
#pragma unroll 4
            for (int pi = 0; pi < 64; ++pi) {
                const int e = __builtin_amdgcn_readlane(idv, pi); const float gate = rdlane(gv, pi);
                const bf16* ur = PU + (size_t)e * 1024; const bf16* vr = PVt + (size_t)e * 1024;
                const u32x4 ua = *(const u32x4*)(ur + 8 * lane), ub = *(const u32x4*)(ur + 512 + 8 * lane);
                const u32x4 va = *(const u32x4*)(vr + 8 * lane), vb = *(const u32x4*)(vr + 512 + 8 * lane);
                float t0[8], t1[8]; unpack8(ua, t0); unpack8(ub, t1);
                float d = 0.f;
#pragma unroll
                for (int k = 0; k < 8; ++k) d += xf[k] * t0[k] + xf[8 + k] * t1[k];
                d = wave_sum(d);
                const float a = gelu_tanh(d) * gate;
                unpack8(va, t0); unpack8(vb, t1);
#pragma unroll
                for (int k = 0; k < 8; ++k) { out[k] += a * t0[k]; out[8 + k] += a * t1[k]; }
            }
        }
        float* xr = p.out + (size_t)tok * 1024;
        const float* g2 = mod + (tok >> 13) * 6144 + 5120;
        const float* fn = p.in[I_FNORM];
        float xn[16]; float ss = 0.f;
#pragma unroll
        for (int hh = 0; hh < 2; ++hh)
#pragma unroll
            for (int k4 = 0; k4 < 2; ++k4) { const int c0 = 512 * hh + 8 * lane + 4 * k4; const f32x4 xv = *(const f32x4*)(xr + c0), gg = *(const f32x4*)(g2 + c0);
#pragma unroll
                for (int j = 0; j < 4; ++j) { const float v = xv[j] + gg[j] * out[8 * hh + 4 * k4 + j]; xn[8 * hh + 4 * k4 + j] = v; ss += v * v; } }
        ss = wave_sum(ss);
        const float rs = 1.0f / sqrtf(ss * (1.0f / 1024.0f) + EPSF);
#pragma unroll
        for (int hh = 0; hh < 2; ++hh)
#pragma unroll
            for (int k4 = 0; k4 < 2; ++k4) { const int c0 = 512 * hh + 8 * lane + 4 * k4; const f32x4 nn = *(const f32x4*)(fn + c0);
                f32x4 o;
#pragma unroll
                for (int j = 0; j < 4; ++j) o[j] = xn[8 * hh + 4 * k4 + j] * rs * nn[j];
                *(f32x4*)(xr + c0) = o; }
    }
}

__device__ __forceinline__ void ph2_inproj(const Params& p, unsigned char* smem) {
    unsigned char* ws = p.ws;
    PG8_LAS unsigned char* lds = (PG8_LAS unsigned char*)smem;
    { pg8::Gemm g{(const pg8::bf16_t*)(ws + WS_A), (const pg8::bf16_t*)(ws + WS_WINT), NTOK, PROJW, DM};
      pg8::StaticOrder S; S.init(NTOK, PROJW, gridDim.x, blockIdx.x);
      static_assert(WS_G == WS_V + (size_t)NTOK * 1024 * 2, "V and G must be contiguous");
      EpiInProj E{(bf16*)(ws + WS_ZT), (bf16*)(ws + WS_QK), (bf16*)(ws + WS_V), (bf16*)p.out, (const float2*)(ws + WS_ROT)};
      pg8::gemm_phase<EpiInProj, pg8::StaticOrder, false>(lds, g, S, E, nullptr); }
    { pg8::Gemm g{(const pg8::bf16_t*)(ws + WS_HCTX), (const pg8::bf16_t*)(ws + WS_WINT) + (size_t)3584 * 1024, NCTX, 1536, DM};
      pg8::StaticOrder S; S.init(NCTX, 1536, gridDim.x, blockIdx.x);
      EpiCtx E{(bf16*)(ws + WS_CK), (bf16*)(ws + WS_CV)};
      pg8::gemm_phase<EpiCtx, pg8::StaticOrder, false>(lds, g, S, E, nullptr); }
}
__device__ __forceinline__ void ph6_merge(const Params& p, unsigned char* smem) {
    unsigned char* ws = p.ws;
    PG8_LAS unsigned char* lds = (PG8_LAS unsigned char*)smem;
    { pg8::Gemm g{(const pg8::bf16_t*)(ws + WS_A), (const pg8::bf16_t*)(ws + WS_WHYT), NTOK, DM, DM};
      pg8::StaticOrder S; S.init(NTOK, DM, gridDim.x, blockIdx.x);
      EpiMerge<0> E{(bf16*)(ws + WS_M), (const bf16*)p.out};
      pg8::gemm_phase<EpiMerge<0>, pg8::StaticOrder, false>(lds, g, S, E, nullptr); }
    { pg8::Gemm g{(const pg8::bf16_t*)(ws + WS_OF), (const pg8::bf16_t*)(ws + WS_WRETT), NTOK, DM, DM};
      pg8::StaticOrder S; S.init(NTOK, DM, gridDim.x, blockIdx.x);
      EpiMerge<1> E{(bf16*)(ws + WS_M), (const bf16*)p.out + (size_t)NTOK * 1024};
      pg8::gemm_phase<EpiMerge<1>, pg8::StaticOrder, false>(lds, g, S, E, nullptr); }
}
__device__ __forceinline__ void ph7_oproj(const Params& p, unsigned char* smem) {
    unsigned char* ws = p.ws;
    PG8_LAS unsigned char* lds = (PG8_LAS unsigned char*)smem;
    pg8::Gemm g{(const pg8::bf16_t*)(ws + WS_M), (const pg8::bf16_t*)(ws + WS_WOT), NTOK, DM, DM};
    pg8::StaticOrder S; S.init(NTOK, DM, gridDim.x, blockIdx.x);
    EpiResid E{p.in[I_X], p.out, (const float*)(ws + WS_MOD)};
    pg8::gemm_phase<EpiResid, pg8::StaticOrder, false>(lds, g, S, E, nullptr);
}
__device__ __forceinline__ void ph9_query(const Params& p, unsigned char* smem) {
    unsigned char* ws = p.ws;
    PG8_LAS unsigned char* lds = (PG8_LAS unsigned char*)smem;
    pg8::Gemm g{(const pg8::bf16_t*)(ws + WS_H2), (const pg8::bf16_t*)(ws + WS_WQT), NTOK, DM, DM};
    pg8::StaticOrder S; S.init(NTOK, DM, gridDim.x, blockIdx.x);
    pg8::EpiBf16<0> E{(pg8::bf16_t*)(ws + WS_QP), DM, nullptr, 0, 0};
    pg8::gemm_phase<pg8::EpiBf16<0>, pg8::StaticOrder, false>(lds, g, S, E, nullptr);
}

#ifndef ONE_LAUNCH
#define ONE_LAUNCH 0
#endif
template <int PH> __device__ __forceinline__ void run_phase(const Params& p, unsigned char* smem) {
    if (PH == 0) ph0_prologue(p, smem);
    if (PH == 1) ph1_rows_and_taps(p, smem);
    if (PH == 2) ph2_inproj(p, smem);
    if (PH == 3) ph3_hyena_conv(p, smem);
    if (PH == 4) { ph4_retention(p, smem); ph4_transpose_yh(p, smem); }
    if (PH == 5) ph5_readout(p);
    if (PH == 6) ph6_merge(p, smem);
    if (PH == 7) ph7_oproj(p, smem);
    if (PH == 8) ph8_rows2(p);
    if (PH == 9) ph9_query(p, smem);
    if (PH == 10) ph10_route(p);
    if (PH == 11) ph11_experts(p);
}
#if ONE_LAUNCH
__global__ void __launch_bounds__(NTHR, 2) fwd_megakernel(Params p) {
    extern __shared__ __attribute__((aligned(16))) unsigned char smem[];
    cg::grid_group grid = cg::this_grid();
    run_phase<0>(p, smem); grid.sync();
    run_phase<1>(p, smem); grid.sync();
    run_phase<2>(p, smem); grid.sync();
    run_phase<3>(p, smem); grid.sync();
    run_phase<4>(p, smem); grid.sync();
    run_phase<5>(p, smem); grid.sync();
    run_phase<6>(p, smem); grid.sync();
    run_phase<7>(p, smem); grid.sync();
    run_phase<8>(p, smem); grid.sync();
    run_phase<9>(p, smem); grid.sync();
    run_phase<10>(p, smem); grid.sync();
    run_phase<11>(p, smem);
}
#else
template <int PH> __global__ void __launch_bounds__(NTHR, 2) k_phase(Params p) {
    extern __shared__ __attribute__((aligned(16))) unsigned char smem[];
    run_phase<PH>(p, smem);
}
#endif

extern "C" void kernel_launch(void* const* d_in, const int* in_sizes, int n_in, void* d_out, int out_size, void* d_ws, size_t ws_size, hipStream_t stream) {
    static int grid = 0;
    if (grid == 0) {
        if (n_in != 31 || out_size != NTOK * DM || ws_size < WS_END) { fprintf(stderr, "kernel_launch: unexpected shapes (n_in %d out %d ws %zu)\n", n_in, out_size, ws_size); grid = -1; return; }
        int dev = 0, cus = 0;
        hipGetDevice(&dev); hipDeviceGetAttribute(&cus, hipDeviceAttributeMultiprocessorCount, dev);
#if ONE_LAUNCH
        int per_cu = 0;
        hipFuncSetAttribute((const void*)fwd_megakernel, hipFuncAttributeMaxDynamicSharedMemorySize, LDS_BYTES);
        hipOccupancyMaxActiveBlocksPerMultiprocessor(&per_cu, (const void*)fwd_megakernel, NTHR, LDS_BYTES);
        if (per_cu < 1) { fprintf(stderr, "kernel_launch: occupancy query says %d blocks/CU\n", per_cu); per_cu = 1; }
        grid = cus;
#else
#define SETATTR(PH) hipFuncSetAttribute((const void*)k_phase<PH>, hipFuncAttributeMaxDynamicSharedMemorySize, LDS_BYTES)
        SETATTR(0); SETATTR(1); SETATTR(2); SETATTR(3); SETATTR(4); SETATTR(5); SETATTR(6); SETATTR(7); SETATTR(8); SETATTR(9); SETATTR(10); SETATTR(11);
#undef SETATTR
        grid = cus;
#endif
        (void)hipGetLastError();
    }
    if (grid < 0) return;
    Params p{};
    for (int i = 0; i < 31; ++i) p.in[i] = (const float*)d_in[i];
    p.out = (float*)d_out; p.ws = (unsigned char*)d_ws;
#if ONE_LAUNCH
    void* args[] = {&p};
    hipError_t e = hipLaunchCooperativeKernel((const void*)fwd_megakernel, dim3(grid), dim3(NTHR), args, LDS_BYTES, stream);
    if (e != hipSuccess) fprintf(stderr, "cooperative launch failed: %s (grid %d)\n", hipGetErrorString(e), grid);
#else
#define LAUNCH(PH) hipLaunchKernelGGL(k_phase<PH>, dim3(grid), dim3(NTHR), LDS_BYTES, stream, p)
    LAUNCH(0); LAUNCH(1); LAUNCH(2); LAUNCH(3); LAUNCH(4); LAUNCH(5); LAUNCH(6); LAUNCH(7); LAUNCH(8); LAUNCH(9); LAUNCH(10); LAUNCH(11);
#undef LAUNCH
#endif
}
```

```cpp
#include <hip/hip_runtime.h>
#include <hip/hip_cooperative_groups.h>
#include <cstdio>
#include <cstdint>
#ifndef PROBE_SEC
#define PROBE_SEC (-1)
#endif
#if PROBE_SEC == 30 || PROBE_SEC == 31
#define PG8_EPI_T0 const unsigned long long _e0 = __builtin_amdgcn_s_memrealtime()
#define PG8_EPI_T1 do { if (PROBE_SEC == 31) asm volatile("s_waitcnt vmcnt(0)" ::: "memory"); const unsigned long long _e1 = __builtin_amdgcn_s_memrealtime(); if (tid == 0) atomicAdd(stamps + blockIdx.x, _e1 - _e0); } while (0)
#else
#define PG8_EPI_T0 do { } while (0)
#define PG8_EPI_T1 do { } while (0)
#endif
namespace pg8 {
#define PG8_LAS __attribute__((address_space(3)))
typedef unsigned short bf16_t;
typedef short bf16x8 __attribute__((ext_vector_type(8)));
typedef float f32x4 __attribute__((ext_vector_type(4)));
typedef unsigned u32x4 __attribute__((ext_vector_type(4)));
constexpr int BM = 256, BK = 64, HALF = 128, HTB = HALF * BK * 2  , STAGE_BYTES = 8 * HTB, NXCD = 8, WGM = 8;

__host__ __device__ __forceinline__ int lds_byte(int r, int c) { const int st = (r >> 4) * 2 + (c >> 5), rr = r & 15, cc = c & 31, ob = rr * 64 + cc * 2; return st * 1024 + (ob ^ (((ob >> 9) & 1) << 5)); }
__host__ __device__ __forceinline__ void stage_rc(int b, int& R, int& C) { const int st = b / 1024, sb = b % 1024, swz = sb ^ (((sb >> 9) & 1) << 5); R = (st >> 1) * 16 + swz / 64; C = (st & 1) * 32 + (swz % 64) / 2; }
__host__ __device__ __forceinline__ int perm32(int rho) { const int n = rho >> 4, i = rho & 15; return 8 * (i >> 2) + 4 * n + (i & 3); }

struct Unit { int pm, pn; };
struct Gemm { const bf16_t* A; const bf16_t* Bt; int M, N, K; };

struct StaticOrder {
    int nM, nN, nwg, G, c;
    __host__ __device__ void init(int M, int N, int G_, int c_) { nM = M / BM; nN = N / BM; nwg = nM * nN; G = G_; c = c_; }
    __host__ __device__ bool next(int i, Unit& u) const {
        const long L = (long)i * G + c; if (L >= nwg) return false;
        int wgid = (int)L; { const int q = nwg / NXCD, r = nwg % NXCD, xcd = wgid % NXCD, off = wgid / NXCD; wgid = (xcd < r ? xcd * (q + 1) : r * (q + 1) + (xcd - r) * q) + off; }
        const int nig = WGM * nN, gid = wgid / nig, fm = gid * WGM, gsz = (nM - fm) < WGM ? (nM - fm) : WGM;
        u.pm = fm + ((wgid % nig) % gsz); u.pn = (wgid % nig) / gsz; return true;
    }
    __device__ __forceinline__ void a_ready(const Unit&) const {}
    __device__ __forceinline__ void done(const Unit&) const {}
};
__device__ __forceinline__ unsigned cvt_pk_bf16(float lo, float hi) { unsigned r; asm volatile("v_cvt_pk_bf16_f32 %0, %1, %2" : "=v"(r) : "v"(lo), "v"(hi)); return r; }
typedef float f32x2 __attribute__((ext_vector_type(2)));
__device__ __forceinline__ f32x2 gelu_pk(f32x2 v) {
    const f32x2 av = __builtin_elementwise_abs(v), d = av * 0.2316418882f + 1.0f;
    f32x2 t; t.x = __builtin_amdgcn_rcpf(d.x); t.y = __builtin_amdgcn_rcpf(d.y);
    f32x2 q = t * 0.5307027145f + (-0.7265760135f); q = q * t + 0.7107068705f; q = q * t + (-0.142248368f); q = q * t + 0.127414796f; q = q * t;
    const f32x2 s = (v * v) * (-0.72134752044f);
    f32x2 e; e.x = __builtin_amdgcn_exp2f(s.x); e.y = __builtin_amdgcn_exp2f(s.y);
    const f32x2 m = v * (q * e), r = v - m;
    f32x2 o; o.x = v.x < 0.f ? m.x : r.x; o.y = v.y < 0.f ? m.y : r.y; return o;
}

struct EpiF32 {
    static constexpr bool PERM = false, AFTER_DRAIN = false;
    float* C; int ldc; const float* bias;
    __device__ __forceinline__ void operator()(const f32x4 (&acc)[2][2][4][2], const Unit& u, int wr, int wc, int fr, int fq) const {
        const int row0 = u.pm * BM + wr * 64 + fr, col0 = u.pn * BM + wc * 32 + 4 * fq;
        f32x4 bv[2][2];
#pragma unroll
        for (int bj = 0; bj < 2; ++bj)
#pragma unroll
            for (int n = 0; n < 2; ++n) bv[bj][n] = bias ? *(const f32x4*)(bias + col0 + bj * HALF + n * 16) : (f32x4){0.f, 0.f, 0.f, 0.f};
#pragma unroll
        for (int ai = 0; ai < 2; ++ai)
#pragma unroll
            for (int m = 0; m < 4; ++m) { float* rowp = C + (size_t)(row0 + ai * HALF + m * 16) * ldc + col0;
#pragma unroll
                for (int bj = 0; bj < 2; ++bj)
#pragma unroll
                    for (int n = 0; n < 2; ++n) *(f32x4*)(rowp + bj * HALF + n * 16) = acc[ai][bj][m][n] + bv[bj][n]; }
    }
};
template <int ACT  > struct EpiBf16 {
    static constexpr bool PERM = true, AFTER_DRAIN = false;
    bf16_t* O; int ldc; const float* bias; int split_cols; size_t split_stride;
    __device__ __forceinline__ void operator()(const f32x4 (&acc)[2][2][4][2], const Unit& u, int wr, int wc, int fr, int fq) const {
        const int row0 = u.pm * BM + wr * 64 + fr; int colt = u.pn * BM; bf16_t* base = O;
        if (split_cols) { const int t = colt / split_cols; base += (size_t)t * split_stride; colt -= t * split_cols; }
        const int col0 = colt + wc * 32 + 8 * fq, bcol0 = u.pn * BM + wc * 32 + 8 * fq;
        f32x4 bv[2][2];
#pragma unroll
        for (int bj = 0; bj < 2; ++bj)
#pragma unroll
            for (int n = 0; n < 2; ++n) bv[bj][n] = bias ? *(const f32x4*)(bias + bcol0 + bj * HALF + 4 * n) : (f32x4){0.f, 0.f, 0.f, 0.f};
#pragma unroll
        for (int ai = 0; ai < 2; ++ai)
#pragma unroll
            for (int m = 0; m < 4; ++m) { bf16_t* rowp = base + (size_t)(row0 + ai * HALF + m * 16) * ldc + col0;
#pragma unroll
                for (int bj = 0; bj < 2; ++bj) { f32x4 v0 = acc[ai][bj][m][0] + bv[bj][0], v1 = acc[ai][bj][m][1] + bv[bj][1];
                    if (ACT == 1) { f32x2 a = gelu_pk((f32x2){v0[0], v0[1]}), b = gelu_pk((f32x2){v0[2], v0[3]}), c = gelu_pk((f32x2){v1[0], v1[1]}), d = gelu_pk((f32x2){v1[2], v1[3]});
                        v0 = (f32x4){a.x, a.y, b.x, b.y}; v1 = (f32x4){c.x, c.y, d.x, d.y}; }
                    if (ACT == 2) {
#pragma unroll
                        for (int j = 0; j < 4; ++j) { v0[j] = 0.5f * v0[j] * (1.0f + erff(v0[j] * 0.70710678f)); v1[j] = 0.5f * v1[j] * (1.0f + erff(v1[j] * 0.70710678f)); } }
                    u32x4 w; w.x = cvt_pk_bf16(v0[0], v0[1]); w.y = cvt_pk_bf16(v0[2], v0[3]); w.z = cvt_pk_bf16(v1[0], v1[1]); w.w = cvt_pk_bf16(v1[2], v1[3]);
                    *(u32x4*)(rowp + bj * HALF) = w; } }
    }
};
template <class Epi, class Sched, bool STAMP = false>
__device__ __forceinline__ void gemm_phase(PG8_LAS unsigned char* lds, const Gemm g, const Sched& S, const Epi& E, unsigned long long* stamps, const int wv_) {
    int tid_; asm volatile("v_mbcnt_lo_u32_b32 %0, -1, 0\n\tv_mbcnt_hi_u32_b32 %0, -1, %0" : "=v"(tid_)); tid_ += 64 * wv_; const int tid = tid_, wid = __builtin_amdgcn_readfirstlane(tid >> 6), lane = tid & 63, wr = wid >> 2, wc = wid & 3, fr = lane & 15, fq = lane >> 4;
    const int K = g.K, nt = K / BK;
    int ts_lo = 0, ts_hi = 0, nts = 0; const unsigned long long rt_entry = STAMP ? (unsigned long long)wall_clock64() : 0ull;
#define PG8_STAMP() do { if (STAMP && wid == 0 && nts < 64) { const unsigned long long _c = (unsigned long long)clock64(); \
        ts_lo = (lane == nts) ? (int)(unsigned)_c : ts_lo; ts_hi = (lane == nts) ? (int)(unsigned)(_c >> 32) : ts_hi; ++nts; } } while (0)
    PG8_STAMP();
    unsigned voffA[2], voffB[2];
#pragma unroll
    for (int i = 0; i < 2; ++i) { int R, C; stage_rc(tid * 16 + i * 8192, R, C); const int Rb = Epi::PERM ? ((R & ~31) + perm32(R & 31)) : R;
        voffA[i] = (unsigned)(R * K + C) * 2u; voffB[i] = (unsigned)(Rb * K + C) * 2u; }
    const size_t kstep = (size_t)(BK * 2);
    const size_t hstep = (size_t)HALF * K * 2;
    const size_t tstep = 2 * hstep;
    const unsigned ldsw = (unsigned)wid * 1024u;
    const int aoff = lds_byte(wr * 64 + fr, fq * 8), boff = lds_byte(wc * 32 + fr, fq * 8);
#define PG8_SA(b, h) (((b) * 2 + (h)) * HTB)
#define PG8_SB(b, h) ((4 + (b) * 2 + (h)) * HTB)
#define PG8_STAGE(bufoff, gbase, voff) do { _Pragma("unroll") for (int _i = 0; _i < 2; ++_i) \
        __builtin_amdgcn_global_load_lds((const unsigned*)((const char*)(gbase) + (voff)[_i]), (PG8_LAS unsigned*)(lds + (bufoff) + ldsw + _i * 8192), 16, 0, 0); } while (0)
#define PG8_LDA(dst, b, h) do { _Pragma("unroll") for (int m = 0; m < 4; ++m) _Pragma("unroll") for (int k = 0; k < 2; ++k) dst[m][k] = *(const PG8_LAS bf16x8*)(lds + PG8_SA(b, h) + aoff + m * 2048 + k * 1024); } while (0)
#define PG8_LDB(dst, b, h) do { _Pragma("unroll") for (int n = 0; n < 2; ++n) _Pragma("unroll") for (int k = 0; k < 2; ++k) dst[n][k] = *(const PG8_LAS bf16x8*)(lds + PG8_SB(b, h) + boff + n * 2048 + k * 1024); } while (0)
#define PG8_MMA(ai, bj, At, Bt) do { __builtin_amdgcn_s_setprio(1); _Pragma("unroll") for (int m = 0; m < 4; ++m) _Pragma("unroll") for (int n = 0; n < 2; ++n) _Pragma("unroll") for (int k = 0; k < 2; ++k) \
        acc[ai][bj][m][n] = __builtin_amdgcn_mfma_f32_16x16x32_bf16(Bt[n][k], At[m][k], acc[ai][bj][m][n], 0, 0, 0); __builtin_amdgcn_s_setprio(0); } while (0)
#define PG8_WAIT_V(n) asm volatile("s_waitcnt vmcnt(" #n ")" ::: "memory")
#define PG8_WAIT_L(n) asm volatile("s_waitcnt lgkmcnt(" #n ")" ::: "memory")
#define PG8_BAR __builtin_amdgcn_s_barrier()
#define PG8_SCHED __builtin_amdgcn_sched_barrier(0)
    Unit cur, nxt; int ui = 0;
    if (!S.next(0, cur)) return;
    f32x4 acc[2][2][4][2];
#pragma unroll
    for (int a = 0; a < 2; ++a)
#pragma unroll
        for (int b = 0; b < 2; ++b)
#pragma unroll
            for (int m = 0; m < 4; ++m)
#pragma unroll
                for (int n = 0; n < 2; ++n) acc[a][b][m][n] = (f32x4){0.f, 0.f, 0.f, 0.f};
    bf16x8 At[4][2], B0[2][2], B1[2][2];
    const char* cA = (const char*)g.A + (size_t)cur.pm * tstep; const char* cB = (const char*)g.Bt + (size_t)cur.pn * tstep;
    S.a_ready(cur);
    PG8_STAGE(PG8_SB(0, 0), cB, voffB); PG8_STAGE(PG8_SA(0, 0), cA, voffA); PG8_STAGE(PG8_SB(0, 1), cB + hstep, voffB); PG8_STAGE(PG8_SA(0, 1), cA + hstep, voffA);
    if (wr == 1) PG8_BAR;
    PG8_WAIT_V(4); PG8_BAR;
    PG8_STAGE(PG8_SB(1, 0), cB + kstep, voffB); PG8_STAGE(PG8_SA(1, 0), cA + kstep, voffA); PG8_STAGE(PG8_SB(1, 1), cB + hstep + kstep, voffB);
    PG8_WAIT_V(6); PG8_BAR;
    PG8_STAMP();
    for (;;) {
        const bool has_next = S.next(ui + 1, nxt);
        const char* nA = has_next ? (const char*)g.A + (size_t)nxt.pm * tstep : cA; const char* nB = has_next ? (const char*)g.Bt + (size_t)nxt.pn * tstep : cB;
        for (int t = 0; t < nt; t += 2) {
            const bool last = (t == nt - 2);
            const char* a1 = cA + (size_t)(t + 1) * kstep;
            const char* a2 = last ? nA : cA + (size_t)(t + 2) * kstep; const char* b2 = last ? nB : cB + (size_t)(t + 2) * kstep;
            const char* a3 = a2 + kstep; const char* b3 = b2 + kstep;
            if (last && has_next) S.a_ready(nxt);
            PG8_LDB(B0, 0, 0); PG8_SCHED; PG8_LDA(At, 0, 0); PG8_STAGE(PG8_SA(1, 1), a1 + hstep, voffA);
            PG8_WAIT_L(8); PG8_BAR; PG8_WAIT_L(0); PG8_MMA(0, 0, At, B0); PG8_BAR; PG8_SCHED;
            PG8_LDB(B1, 0, 1); PG8_STAGE(PG8_SB(0, 0), b2, voffB);
            PG8_BAR; PG8_WAIT_L(0); PG8_MMA(0, 1, At, B1); PG8_BAR;
            PG8_LDA(At, 0, 1); PG8_STAGE(PG8_SA(0, 0), a2, voffA);
            PG8_BAR; PG8_WAIT_L(0); PG8_MMA(1, 0, At, B0); PG8_BAR; PG8_SCHED;
            PG8_STAGE(PG8_SB(0, 1), b2 + hstep, voffB);
            PG8_WAIT_V(6); PG8_BAR; PG8_MMA(1, 1, At, B1); PG8_BAR;
            PG8_LDB(B0, 1, 0); PG8_SCHED; PG8_LDA(At, 1, 0); PG8_STAGE(PG8_SA(0, 1), a2 + hstep, voffA);
            PG8_WAIT_L(8); PG8_BAR; PG8_WAIT_L(0); PG8_MMA(0, 0, At, B0); PG8_BAR; PG8_SCHED;
            PG8_LDB(B1, 1, 1); PG8_STAGE(PG8_SB(1, 0), b3, voffB);
            PG8_BAR; PG8_WAIT_L(0); PG8_MMA(0, 1, At, B1); PG8_BAR;
            PG8_LDA(At, 1, 1); PG8_STAGE(PG8_SA(1, 0), a3, voffA);
            PG8_BAR; PG8_WAIT_L(0); PG8_MMA(1, 0, At, B0); PG8_BAR; PG8_SCHED;
            PG8_STAGE(PG8_SB(1, 1), b3 + hstep, voffB);
            PG8_WAIT_V(6); PG8_BAR; PG8_MMA(1, 1, At, B1); PG8_BAR;
        }
        PG8_STAMP();
        if constexpr (!Epi::AFTER_DRAIN) { PG8_EPI_T0; E(acc, cur, wr, wc, fr, fq); PG8_EPI_T1; S.done(cur); }
        PG8_STAMP();
        if (!has_next) break;
#pragma unroll
        for (int a = 0; a < 2; ++a)
#pragma unroll
            for (int b = 0; b < 2; ++b)
#pragma unroll
                for (int m = 0; m < 4; ++m)
#pragma unroll
                    for (int n = 0; n < 2; ++n) acc[a][b][m][n] = (f32x4){0.f, 0.f, 0.f, 0.f};
        cur = nxt; cA = nA; cB = nB; ++ui;
    }
    PG8_WAIT_V(0);
    if (wr == 0) PG8_BAR;
    PG8_BAR;
    if constexpr (Epi::AFTER_DRAIN) { E.fused(acc, cur, wr, wc, fr, fq, lds, wid, lane); S.done(cur); }
    PG8_STAMP();
    if (STAMP && wid == 0) { stamps[lane] = lane < nts ? (((unsigned long long)(unsigned)ts_hi << 32) | (unsigned)ts_lo) : 0ull;
        if (lane == 62) stamps[62] = rt_entry; if (lane == 63) stamps[63] = (unsigned long long)wall_clock64(); }
#undef PG8_STAMP
#undef PG8_SA
#undef PG8_SB
#undef PG8_STAGE
#undef PG8_LDA
#undef PG8_LDB
#undef PG8_MMA
#undef PG8_WAIT_V
#undef PG8_WAIT_L
#undef PG8_BAR
#undef PG8_SCHED
}
}

namespace cg = cooperative_groups;
#define LAS __attribute__((address_space(3)))
typedef unsigned short bf16;
typedef short bf16x8 __attribute__((ext_vector_type(8)));
typedef float f32x4 __attribute__((ext_vector_type(4)));
typedef unsigned u32x4 __attribute__((ext_vector_type(4)));
typedef unsigned u32x2 __attribute__((ext_vector_type(2)));
typedef float f32x2 __attribute__((ext_vector_type(2)));

constexpr int DM = 1024, NB = 8, SEQ = 8192, NTOK = NB * SEQ, CTXL = 256, NCTX = NB * CTXL, PROJW = 8192;
constexpr int NTHR = 512;
constexpr int LDS_BYTES = 160 * 1024;
constexpr float EPSF = 1e-6f;

constexpr size_t MiB = 1ull << 20, KiB = 1ull << 10;
constexpr size_t WS_WINT = 0, WS_WHYT = 16 * MiB, WS_WRETT = 18 * MiB, WS_WOT = 20 * MiB, WS_WQT = 22 * MiB;
constexpr size_t WS_KERN2 = 24 * MiB;
constexpr size_t WS_PU = 24 * MiB, WS_PV = 56 * MiB;
constexpr size_t WS_MISC = 88 * MiB;
constexpr size_t WS_MOD = WS_MISC, WS_ROT = WS_MISC + 256 * KiB, WS_GFEAT = WS_MISC + 512 * KiB, WS_KPART = WS_MISC + 3 * MiB,
                 WS_HCTX = WS_MISC + 5 * MiB, WS_CK = WS_MISC + 9 * MiB, WS_CV = WS_MISC + 11 * MiB;
constexpr size_t WS_A = 104 * MiB;
constexpr size_t WS_ZT = 232 * MiB;
constexpr size_t WS_X0T = 232 * MiB, WS_X1T = 360 * MiB, WS_VT = 488 * MiB;
constexpr size_t WS_QK = 616 * MiB, WS_V = 744 * MiB, WS_G = 872 * MiB, WS_END = 1004 * MiB;
constexpr size_t WS_FPIMG = WS_MISC + 15 * MiB, WS_FNAT = WS_MISC + 15 * MiB + 64 * KiB;
constexpr size_t WS_BAR = WS_MISC + 15 * MiB + 128 * KiB;
constexpr size_t WS_SUBK16 = WS_MISC + 15 * MiB + 256 * KiB;
constexpr size_t WS_FW4T = WS_MISC + 15 * MiB + 512 * KiB;
constexpr size_t WS_KPART2 = 1000 * MiB;
constexpr size_t WS_HBUF = WS_A;
constexpr size_t WS_X8 = WS_X1T + 64 * MiB;
constexpr size_t WS_YHT = WS_X1T, WS_YH = WS_X0T;
constexpr size_t WS_OF = WS_A, WS_OB = WS_VT, WS_M = WS_QK, WS_H2 = WS_VT, WS_QP = WS_G, WS_RIDX = WS_X1T, WS_RGATE = WS_X1T + 32 * MiB;

#define PG8_PROBE_PTR ((PROBE_SEC == 30 || PROBE_SEC == 31) ? (unsigned long long*)(ws + WS_BAR) : (unsigned long long*)nullptr)
struct Params {
    const float* in[31];
    float* out;
    unsigned char* ws;
};
#ifndef PROBE_SEC
#define PROBE_SEC (-1)
#endif
#define SEC_BEGIN(id) unsigned long long _sec_t0_##id = 0ull; if (PROBE_SEC == (id)) _sec_t0_##id = __builtin_amdgcn_s_memrealtime()
#define SEC_END(id, wsptr) do { if (PROBE_SEC == (id)) { const unsigned long long _dt = __builtin_amdgcn_s_memrealtime() - _sec_t0_##id; \
        if (threadIdx.x == 0) atomicAdd((unsigned long long*)((wsptr) + WS_BAR) + blockIdx.x, _dt); } } while (0)
enum { I_X = 0, I_C, I_CTX, I_CCTX, I_WADA, I_BADA, I_NORM1, I_NORM2, I_WIN, I_HCW, I_HCB, I_FW1, I_FB1, I_FW2, I_FB2, I_FW3, I_FB3, I_FW4, I_FREQ, I_DELTAS, I_HBIAS,
       I_LGF, I_LGB, I_WHY, I_WRET, I_WO, I_WQ, I_SUBK, I_PU, I_PV, I_FNORM };

__device__ __forceinline__ unsigned f2bf(float f) { unsigned u = __float_as_uint(f); return (u + 0x7fffu + ((u >> 16) & 1u)) >> 16; }
__device__ __forceinline__ unsigned pk2(float lo, float hi) { return f2bf(lo) | (f2bf(hi) << 16); }
__device__ __forceinline__ float bf_lo(unsigned w) { return __uint_as_float(w << 16); }
__device__ __forceinline__ float bf_hi(unsigned w) { return __uint_as_float(w & 0xffff0000u); }
__device__ __forceinline__ float bf1(bf16 h) { return __uint_as_float(((unsigned)h) << 16); }
__device__ __forceinline__ float wave_sum(float v) {
#pragma unroll
    for (int o = 1; o < 64; o <<= 1) v += __shfl_xor(v, o);
    return v;
}
__device__ __forceinline__ float wave_sum_dpp(float v) {
    v += __int_as_float(__builtin_amdgcn_update_dpp(0, __float_as_int(v), 0xB1, 0xF, 0xF, false));
    v += __int_as_float(__builtin_amdgcn_update_dpp(0, __float_as_int(v), 0x4E, 0xF, 0xF, false));
    v += __int_as_float(__builtin_amdgcn_update_dpp(0, __float_as_int(v), 0x141, 0xF, 0xF, false));
    v += __int_as_float(__builtin_amdgcn_update_dpp(0, __float_as_int(v), 0x140, 0xF, 0xF, false));
    v += __int_as_float(__builtin_amdgcn_update_dpp(0, __float_as_int(v), 0x142, 0xA, 0xF, false));
    v += __int_as_float(__builtin_amdgcn_update_dpp(0, __float_as_int(v), 0x143, 0xC, 0xF, false));
    return __int_as_float(__builtin_amdgcn_readlane(__float_as_int(v), 63));
}
__device__ __forceinline__ size_t gate_off(int row, int col) { return (size_t)(row >> 8) * 524288 + (size_t)(row & 255) * 1024 + col; }
__device__ __forceinline__ float sigmoidf_(float x) { return __builtin_amdgcn_rcpf(1.0f + __expf(-x)); }
__device__ __forceinline__ int opaque_tid(const int wv) { int l; asm volatile("v_mbcnt_lo_u32_b32 %0, -1, 0\n\tv_mbcnt_hi_u32_b32 %0, -1, %0" : "=v"(l)); return l + 64 * wv; }
__device__ __forceinline__ float rdlane(float v, int l) { return __int_as_float(__builtin_amdgcn_readlane(__float_as_int(v), l)); }


__device__ __forceinline__ void sincos_f(float x, float& s, float& c) {
    const float k = rintf(x * 0.636619772367581343f);
    const int qd = (int)k;
    float r = fmaf(-k, 1.57079625129699707031e+00f, x);
    r = fmaf(-k, 7.54978941586159635335e-08f, r);
    r = fmaf(-k, 5.39030295347424192935e-15f, r);
    const float r2 = r * r;
    const float sp = r + r * r2 * (-1.6666654611e-1f + r2 * (8.3321608736e-3f - r2 * 1.9515295891e-4f));
    const float cp = 1.0f - 0.5f * r2 + r2 * r2 * (4.166664568298827e-2f + r2 * (-1.388731625493765e-3f + r2 * 2.443315711809948e-5f));
    const float s1 = (qd & 1) ? cp : sp, c1 = (qd & 1) ? sp : cp;
    s = (qd & 2) ? -s1 : s1;
    c = ((qd + 1) & 2) ? -c1 : c1;
}
__device__ __forceinline__ float sin_f(float x) { float s, c; sincos_f(x, s, c); return s; }

__device__ __forceinline__ int win_dst_row(int n) {
    if (n >= 3072 && n < 4096) { const int e = n & 63; const int pp = (e < 32) ? (8 * (e >> 2) + (e & 3)) : (8 * ((e - 32) >> 2) + 4 + (e & 3)); return (n & ~63) + pp; }
    return n;
}
__device__ __forceinline__ void transpose_item(const float* __restrict__ W, int K, int N, bf16* __restrict__ WT, LAS float* scr, int item, int lane, bool permute) {
    const int nblk = N / 32, kb = item / nblk, nb = item % nblk, k0 = 64 * kb, n0 = 32 * nb;
#pragma unroll 8
    for (int i = 0; i < 32; ++i) { const int kk = 2 * i + (lane >> 5); scr[kk * 33 + (lane & 31)] = W[(size_t)(k0 + kk) * N + n0 + (lane & 31)]; }
    __builtin_amdgcn_s_waitcnt(0xC07F); asm volatile("" ::: "memory");
    const int c = lane & 7;
#pragma unroll
    for (int j = 0; j < 4; ++j) { const int n = (lane >> 3) + 8 * j; const LAS float* s = scr + (8 * c) * 33 + n;
        u32x4 o; o.x = pk2(s[0 * 33], s[1 * 33]); o.y = pk2(s[2 * 33], s[3 * 33]); o.z = pk2(s[4 * 33], s[5 * 33]); o.w = pk2(s[6 * 33], s[7 * 33]);
        const int nd = permute ? win_dst_row(n0 + n) : (n0 + n);
        *(u32x4*)(WT + (size_t)nd * K + k0 + 8 * c) = o; }
    __builtin_amdgcn_s_waitcnt(0xC07F); asm volatile("" ::: "memory");
}

__device__ __forceinline__ void ph0_prologue(const int wv, const Params& p, unsigned char* smem) {
    const int tid = opaque_tid(wv), lane = tid & 63, wave = __builtin_amdgcn_readfirstlane(tid >> 6);
    const int gw = blockIdx.x * 8 + wave, NGW = gridDim.x * 8;
    unsigned char* ws = p.ws;
#ifndef P0M
#define P0M 15
#endif
#if P0M & 1
    {
        LAS float* st = (LAS float*)(LAS unsigned char*)smem;
        LAS float* red = (LAS float*)((LAS unsigned char*)smem + 36864);
        float* mod = (float*)(ws + WS_MOD);
        const float* wada = p.in[I_WADA];
        for (int item = blockIdx.x; item < 96; item += gridDim.x) {
            for (int i = tid; i < 9 * 1024; i += NTHR) { const int r = i >> 10, k = i & 1023; const float v = (r < 8) ? p.in[I_C][r * 1024 + k] : p.in[I_CCTX][k]; st[i] = v / (1.0f + __expf(-v)); }
            __syncthreads();
            const int j = item * 64 + lane;
            float acc[9];
#pragma unroll
            for (int r = 0; r < 9; ++r) acc[r] = 0.f;
            const int k0 = wave * 128;
#pragma unroll 16
            for (int k = k0; k < k0 + 128; ++k) { const float w = wada[(size_t)k * 6144 + j];
#pragma unroll
                for (int r = 0; r < 9; ++r) acc[r] += st[r * 1024 + k] * w; }
#pragma unroll
            for (int r = 0; r < 9; ++r) red[(wave * 9 + r) * 64 + lane] = acc[r];
            __syncthreads();
            for (int o = tid; o < 576; o += NTHR) { const int r = o >> 6, l = o & 63; float s = p.in[I_BADA][item * 64 + l];
#pragma unroll
                for (int w = 0; w < 8; ++w) s += red[(w * 9 + r) * 64 + l];
                mod[r * 6144 + item * 64 + l] = s; }
            __syncthreads();
        }
    }
#endif
#if P0M & 2
    {
        float2* rot = (float2*)(ws + WS_ROT);
        const int gt = blockIdx.x * NTHR + tid;
        if (gt < 4096) { const int pos = gt >> 5, f = gt & 31; const float inv = exp2f(-(float)f * (13.287712379549449f / 32.0f)); const float ang = (float)pos * inv; float sn, cs_; sincos_f(ang, sn, cs_); rot[gt] = make_float2(cs_, sn); }
    }
#endif
#if P0M & 4
    {
        const int gt = blockIdx.x * NTHR + tid;
        if (gt < 131072) { const int cc = gt >> 6, jj = gt & 63; ((bf16*)(ws + WS_FW4T))[gt] = (bf16)f2bf(p.in[I_FW4][(size_t)jj * 2048 + cc]); }
        if (gt < 131072 / 8) { const f32x4 a = *(const f32x4*)(p.in[I_SUBK] + 8 * gt), b2 = *(const f32x4*)(p.in[I_SUBK] + 8 * gt + 4);
            u32x4 o; o.x = pk2(a.x, a.y); o.y = pk2(a.z, a.w); o.z = pk2(b2.x, b2.y); o.w = pk2(b2.z, b2.w); *(u32x4*)((bf16*)(ws + WS_SUBK16) + 8 * gt) = o; }
        if (gt < 16384) { const int row = gt >> 7, col = gt & 127;
            bf16* fnat = (bf16*)(ws + WS_FNAT); bf16* fimg = (bf16*)(ws + WS_FPIMG);
            { float sn, cs_; sincos_f(0.04908738521234052f * (float)((row * col) & 127), sn, cs_); fnat[gt] = (bf16)f2bf(cs_); fnat[16384 + gt] = (bf16)f2bf(-sn); }
            { const int ks_ = col >> 5, qq = (col >> 3) & 3, jj = col & 7; const int kc = 32 * ks_ + (jj < 4 ? 4 * qq + jj : 16 + 4 * qq + (jj - 4));
              float sn, cs_; sincos_f(0.04908738521234052f * (float)((row * kc) & 127), sn, cs_);
              const int off = (row * 256 + ((((col >> 3) ^ ((row ^ (row >> 3)) & 15))) << 4) + ((col & 7) << 1)) >> 1;
              fimg[off] = (bf16)f2bf(cs_); fimg[16384 + off] = (bf16)f2bf(-sn); }
        }
    }
    {
        const float *fw1 = p.in[I_FW1], *fb1 = p.in[I_FB1], *fw2 = p.in[I_FW2], *fb2 = p.in[I_FB2], *fw3 = p.in[I_FW3], *fb3 = p.in[I_FB3], *freq = p.in[I_FREQ];
        float* gfeat = (float*)(ws + WS_GFEAT);
        const float fq = freq[lane];
        LAS float* hb = (LAS float*)((LAS unsigned char*)smem + 65536 + wave * 1024);
        for (int t0 = gw * 4; t0 < SEQ; t0 += NGW * 4) {
            float a[4];
#pragma unroll
            for (int u = 0; u < 4; ++u) { const int t = t0 + u;
                const float tl = (float)t / 8191.0f;
                const float w = 7.66990393942820614859e-4f * (float)t;
                float zz = 0.f;
                if (lane == 0) zz = tl;
                else if (lane <= 16) { const float band = 1e-4f + (float)(lane - 1) * ((15.0f - 1e-4f) / 15.0f); float sn, cs_; sincos_f(band * w, sn, cs_); zz = cs_; }
                else if (lane <= 32) { const float band = 1e-4f + (float)(lane - 17) * ((15.0f - 1e-4f) / 15.0f); zz = -sin_f(band * w); }
                hb[u * 64 + lane] = zz; a[u] = fb1[lane]; }
            __builtin_amdgcn_s_waitcnt(0xC07F); asm volatile("" ::: "memory");
#pragma unroll 11
            for (int i = 0; i < 33; ++i) { const float wv = fw1[i * 64 + lane];
#pragma unroll
                for (int u = 0; u < 4; ++u) a[u] += hb[u * 64 + i] * wv; }
            asm volatile("" ::: "memory");
#pragma unroll
            for (int u = 0; u < 4; ++u) { hb[u * 64 + lane] = sin_f(fq * a[u]); a[u] = fb2[lane]; }
            __builtin_amdgcn_s_waitcnt(0xC07F); asm volatile("" ::: "memory");
#pragma unroll 16
            for (int i = 0; i < 64; ++i) { const float wv = fw2[i * 64 + lane];
#pragma unroll
                for (int u = 0; u < 4; ++u) a[u] += hb[u * 64 + i] * wv; }
            asm volatile("" ::: "memory");
#pragma unroll
            for (int u = 0; u < 4; ++u) { hb[u * 64 + lane] = sin_f(fq * a[u]); a[u] = fb3[lane]; }
            __builtin_amdgcn_s_waitcnt(0xC07F); asm volatile("" ::: "memory");
#pragma unroll 16
            for (int i = 0; i < 64; ++i) { const float wv = fw3[i * 64 + lane];
#pragma unroll
                for (int u = 0; u < 4; ++u) a[u] += hb[u * 64 + i] * wv; }
            asm volatile("" ::: "memory");
#pragma unroll
            for (int u = 0; u < 4; ++u) ((bf16*)gfeat)[(t0 + u) * 64 + lane] = (bf16)f2bf(sin_f(fq * a[u]));
        }
    }
#endif
#if P0M & 8
    __syncthreads();
    {
        LAS float* scr = (LAS float*)((LAS unsigned char*)smem + wave * 8448);
        constexpr int I_IN = 16 * 256, I_SQ = 16 * 32;
        constexpr int NITEMS = I_IN + 4 * I_SQ;
        for (int it = gw; it < NITEMS; it += NGW) {
            int r = it;
            if (r < I_IN) { transpose_item(p.in[I_WIN], 1024, 8192, (bf16*)(ws + WS_WINT), scr, r, lane, true); continue; } r -= I_IN;
            if (r < I_SQ) { transpose_item(p.in[I_WHY], 1024, 1024, (bf16*)(ws + WS_WHYT), scr, r, lane, false); continue; } r -= I_SQ;
            if (r < I_SQ) { transpose_item(p.in[I_WRET], 1024, 1024, (bf16*)(ws + WS_WRETT), scr, r, lane, false); continue; } r -= I_SQ;
            if (r < I_SQ) { transpose_item(p.in[I_WO], 1024, 1024, (bf16*)(ws + WS_WOT), scr, r, lane, false); continue; } r -= I_SQ;
            transpose_item(p.in[I_WQ], 1024, 1024, (bf16*)(ws + WS_WQT), scr, r, lane, false);
        }
    }
#endif
}

__device__ __forceinline__ void norm_mod_row(const float* xr, const float* gain, const float* shift, const float* scale, bf16* dst, int lane) {
    f32x4 v[4]; float ss = 0.f;
#pragma unroll
    for (int j = 0; j < 4; ++j) { v[j] = *(const f32x4*)(xr + 4 * lane + 256 * j); ss += (v[j].x * v[j].x + v[j].y * v[j].y) + (v[j].z * v[j].z + v[j].w * v[j].w); }
    ss = wave_sum(ss);
    const float rs = 1.0f / sqrtf(ss * (1.0f / 1024.0f) + EPSF);
#pragma unroll
    for (int j = 0; j < 4; ++j) { const int c0 = 4 * lane + 256 * j;
        const f32x4 n = *(const f32x4*)(gain + c0), sc = *(const f32x4*)(scale + c0), sh = *(const f32x4*)(shift + c0);
        const f32x4 y = v[j] * rs * n * (sc + 1.0f) + sh;
        u32x2 o; o.x = pk2(y.x, y.y); o.y = pk2(y.z, y.w);
        *(u32x2*)(dst + c0) = o; }
}

__device__ __forceinline__ void ph1_rows_and_taps(const int wv, const Params& p, unsigned char* smem) {
    const int tid = opaque_tid(wv), lane = tid & 63, wave = __builtin_amdgcn_readfirstlane(tid >> 6);
    const int gw = blockIdx.x * 8 + wave, NGW = gridDim.x * 8;
    unsigned char* ws = p.ws;
    const float* mod = (const float*)(ws + WS_MOD);
    { SEC_BEGIN(1);
        const int r16 = lane & 15, q = lane >> 4;
        const bf16* gf16 = (const bf16*)(ws + WS_GFEAT); const bf16* fw4t = (const bf16*)(ws + WS_FW4T);
        bf16* kern2 = (bf16*)(ws + WS_KERN2); float* kpart = (float*)(ws + WS_KPART2);
        for (int un = gw; un < 2048; un += NGW) {
            const int tt = un >> 2, cq = un & 3;
            const u32x4 A0 = *(const u32x4*)(gf16 + (size_t)(16 * tt + r16) * 64 + 8 * q), A1 = *(const u32x4*)(gf16 + (size_t)(16 * tt + r16) * 64 + 32 + 8 * q);
            const int t0 = 16 * tt + 4 * q;
#pragma unroll 4
            for (int ct = 0; ct < 32; ++ct) {
                const int cp = 512 * cq + 16 * ct + r16, c = cp & 1023; const bool bwd = cp >= 1024;
                const u32x4 B0 = *(const u32x4*)(fw4t + (size_t)cp * 64 + 8 * q), B1 = *(const u32x4*)(fw4t + (size_t)cp * 64 + 32 + 8 * q);
                f32x4 acc = (f32x4){0.f, 0.f, 0.f, 0.f};
                acc = __builtin_amdgcn_mfma_f32_16x16x32_bf16(__builtin_bit_cast(bf16x8, A0), __builtin_bit_cast(bf16x8, B0), acc, 0, 0, 0);
                acc = __builtin_amdgcn_mfma_f32_16x16x32_bf16(__builtin_bit_cast(bf16x8, A1), __builtin_bit_cast(bf16x8, B1), acc, 0, 0, 0);
                const float ad = fabsf(p.in[I_DELTAS][c]) * (1.0f / 8191.0f);
                const float e0 = expf(-(float)t0 * ad), st = expf(-ad);
                f32x4 o; float part = 0.f, e = e0;
#pragma unroll
                for (int r = 0; r < 4; ++r) { const float val = acc[r] * e; e *= st; o[r] = val; if (!bwd || t0 + r > 0) part += fabsf(val); }
                { u32x2 o2; o2.x = pk2(o[0], o[1]); o2.y = pk2(o[2], o[3]); *(u32x2*)(kern2 + (size_t)c * 16384 + (bwd ? 8192 : 0) + t0) = o2; }
                part += __shfl_xor(part, 16); part += __shfl_xor(part, 32);
                if (q == 0) kpart[(size_t)tt * 2048 + cp] = part;
            }
        }
      SEC_END(1, ws); }
    {
        f32x4 vn[4];
        { const int r = gw; const float* xr = r >= NTOK ? p.in[I_CTX] + (size_t)(r - NTOK) * 1024 : p.in[I_X] + (size_t)r * 1024;
#pragma unroll
          for (int j = 0; j < 4; ++j) vn[j] = *(const f32x4*)(xr + 4 * lane + 256 * j); }
        for (int r = gw; r < NTOK + NCTX; r += NGW) {
            const bool isc = r >= NTOK;
            const float* md = mod + (isc ? 8 : (r >> 13)) * 6144;
            bf16* dst = isc ? (bf16*)(ws + WS_HCTX) + (size_t)(r - NTOK) * 1024 : (bf16*)(ws + WS_A) + (size_t)r * 1024;
            f32x4 v[4], gn[4], sc[4], sh[4];
#pragma unroll
            for (int j = 0; j < 4; ++j) { v[j] = vn[j]; const int c0 = 4 * lane + 256 * j; gn[j] = *(const f32x4*)(p.in[I_NORM1] + c0); sh[j] = *(const f32x4*)(md + c0); sc[j] = *(const f32x4*)(md + 1024 + c0); }
            asm volatile("" ::: "memory");
            { const int rn = (r + NGW < NTOK + NCTX) ? r + NGW : r; const float* xr = rn >= NTOK ? p.in[I_CTX] + (size_t)(rn - NTOK) * 1024 : p.in[I_X] + (size_t)rn * 1024;
#pragma unroll
              for (int j = 0; j < 4; ++j) vn[j] = *(const f32x4*)(xr + 4 * lane + 256 * j); }
            asm volatile("" ::: "memory");
            float ss = 0.f;
#pragma unroll
            for (int j = 0; j < 4; ++j) ss += (v[j].x * v[j].x + v[j].y * v[j].y) + (v[j].z * v[j].z + v[j].w * v[j].w);
            ss = wave_sum(ss);
            const float rs = 1.0f / sqrtf(ss * (1.0f / 1024.0f) + EPSF);
#pragma unroll
            for (int j = 0; j < 4; ++j) { const int c0 = 4 * lane + 256 * j;
                const f32x4 y = v[j] * rs * gn[j] * (sc[j] + 1.0f) + sh[j];
                u32x2 o; o.x = pk2(y.x, y.y); o.y = pk2(y.z, y.w);
                *(u32x2*)(dst + c0) = o; }
        }
    }
}

struct EpiInProj {
    static constexpr bool PERM = true, AFTER_DRAIN = false;
    bf16* zT; bf16* QK; bf16* VG; bf16* AHR; const float2* rot;
    __device__ __forceinline__ void operator()(const pg8::f32x4 (&acc)[2][2][4][2], const pg8::Unit& u, int wr, int wc, int fr, int fq) const {
        const int pn = u.pn;
        const int row0 = u.pm * 256 + wr * 64 + fr;
        const int colw = wc * 32 + 8 * fq;
#ifndef EPM
#define EPM 7
#endif
        if ((EPM & 1) && pn < 12) {
            SEC_BEGIN(32);
            const int sec = pn >> 2, cbase = (pn & 3) * 256;
#pragma unroll
            for (int ai = 0; ai < 2; ++ai)
#pragma unroll
                for (int m = 0; m < 4; ++m) { const int row = row0 + ai * 128 + m * 16; const int b = row >> 13, t = row & 8191;
#pragma unroll
                    for (int bj = 0; bj < 2; ++bj) { const int c = cbase + bj * 128 + colw;
                        bf16* dst = zT + ((size_t)((sec * NB + b) * 1024 + c)) * SEQ + t;
#pragma unroll
                        for (int n = 0; n < 2; ++n)
#pragma unroll
                            for (int j = 0; j < 4; ++j) dst[(size_t)(4 * n + j) * SEQ] = (bf16)f2bf(acc[ai][bj][m][n][j]); }
                    asm volatile("" ::: "memory"); }
            SEC_END(32, (unsigned char*)zT - WS_ZT);
        } else if ((EPM & 2) && pn < 16) {
            const float scale = (pn >= 14) ? 0.08838834764831845f : 1.0f;
#pragma unroll
            for (int ai = 0; ai < 2; ++ai)
#pragma unroll
                for (int m = 0; m < 4; ++m) { const int row = row0 + ai * 128 + m * 16; const int t = row & 8191; const int prow = t >> 6, pcol = t & 63;
#pragma unroll
                    for (int bj = 0; bj < 2; ++bj) { const int cc = (pn - 12) * 256 + bj * 128 + colw;
                        const int half = (cc >> 6) & 1, g = (cc & 63) >> 3; const int pos = half ? pcol : prow;
                        const float2* rp = rot + pos * 32 + 4 * g;
                        float o1[4], o2[4];
#pragma unroll
                        for (int j = 0; j < 4; ++j) { const float2 cs = rp[j]; const float x1 = acc[ai][bj][m][0][j], x2 = acc[ai][bj][m][1][j];
                            o1[j] = (x1 * cs.x - x2 * cs.y) * scale; o2[j] = (x1 * cs.y + x2 * cs.x) * scale; }
                        bf16* dst = QK + (size_t)row * 1024 + (cc & ~63) + 4 * g;
                        u32x2 a, b2; a.x = pk2(o1[0], o1[1]); a.y = pk2(o1[2], o1[3]); b2.x = pk2(o2[0], o2[1]); b2.y = pk2(o2[2], o2[3]);
                        *(u32x2*)dst = a; *(u32x2*)(dst + 32) = b2; }
                    asm volatile("" ::: "memory"); }
        } else if (EPM & 4) {
            const bool isg = pn >= 24;
            bf16* base = isg ? AHR + (size_t)((pn >> 2) & 1) * 262144 : VG + (size_t)((pn >> 2) & 1) * ((size_t)NTOK * 1024);
            const int act = pn < 20 ? 0 : (pn < 24 ? 1 : 2);
#pragma unroll
            for (int ai = 0; ai < 2; ++ai)
#pragma unroll
                for (int m = 0; m < 4; ++m) { const int row = row0 + ai * 128 + m * 16;
#pragma unroll
                    for (int bj = 0; bj < 2; ++bj) { const int cc = (pn & 3) * 256 + bj * 128 + colw;
                        float v[8];
#pragma unroll
                        for (int n = 0; n < 2; ++n)
#pragma unroll
                            for (int j = 0; j < 4; ++j) { const float x = acc[ai][bj][m][n][j]; const float sg = sigmoidf_(x); v[4 * n + j] = act == 0 ? x : (act == 1 ? x * sg : sg); }
                        u32x4 w; w.x = pk2(v[0], v[1]); w.y = pk2(v[2], v[3]); w.z = pk2(v[4], v[5]); w.w = pk2(v[6], v[7]);
                        *(u32x4*)(base + (isg ? gate_off(row, cc) : (size_t)row * 1024 + cc)) = w; }
                    asm volatile("" ::: "memory"); }
        }
    }
};
struct EpiCtx {
    static constexpr bool PERM = true, AFTER_DRAIN = false;
    bf16* CK; bf16* CV;
    __device__ __forceinline__ void operator()(const pg8::f32x4 (&acc)[2][2][4][2], const pg8::Unit& u, int wr, int wc, int fr, int fq) const {
        const int pn = u.pn;
        const int row0 = u.pm * 256 + wr * 64 + fr;
        const int colw = wc * 32 + 8 * fq;
#pragma unroll
        for (int ai = 0; ai < 2; ++ai)
#pragma unroll
            for (int m = 0; m < 4; ++m) { const int row = row0 + ai * 128 + m * 16;
#pragma unroll
                for (int bj = 0; bj < 2; ++bj) {
                    if (pn < 2) { const int cc = pn * 256 + bj * 128 + colw; const int g = (cc & 63) >> 3; const float scale = 0.08838834764831845f;
                        bf16* dst = CK + (size_t)row * 512 + (cc & ~63) + 4 * g;
                        u32x2 a, b2; a.x = pk2(acc[ai][bj][m][0][0] * scale, acc[ai][bj][m][0][1] * scale); a.y = pk2(acc[ai][bj][m][0][2] * scale, acc[ai][bj][m][0][3] * scale);
                        b2.x = pk2(acc[ai][bj][m][1][0] * scale, acc[ai][bj][m][1][1] * scale); b2.y = pk2(acc[ai][bj][m][1][2] * scale, acc[ai][bj][m][1][3] * scale);
                        *(u32x2*)dst = a; *(u32x2*)(dst + 32) = b2;
                    } else { const int cc = (pn - 2) * 256 + bj * 128 + colw;
                        u32x4 w; w.x = pk2(acc[ai][bj][m][0][0], acc[ai][bj][m][0][1]); w.y = pk2(acc[ai][bj][m][0][2], acc[ai][bj][m][0][3]);
                        w.z = pk2(acc[ai][bj][m][1][0], acc[ai][bj][m][1][1]); w.w = pk2(acc[ai][bj][m][1][2], acc[ai][bj][m][1][3]);
                        *(u32x4*)(CV + (size_t)row * 1024 + cc) = w; } } }
    }
};
template <int PASS> struct EpiMerge {
    static constexpr bool PERM = true, AFTER_DRAIN = false;
    bf16* Mo; const bf16* gate;
    __device__ __forceinline__ void operator()(const pg8::f32x4 (&acc)[2][2][4][2], const pg8::Unit& u, int wr, int wc, int fr, int fq) const {
        int fro = fr; asm volatile("" : "+v"(fro));
        const int row0 = u.pm * 256 + wr * 64 + fro; const int col0 = u.pn * 256 + wc * 32 + 8 * fq;
#pragma unroll
        for (int ai = 0; ai < 2; ++ai)
#pragma unroll
            for (int mh = 0; mh < 1; ++mh) {
                u32x4 gw[4][2], pw[4][2];
#pragma unroll
                for (int mm = 0; mm < 4; ++mm)
#pragma unroll
                    for (int bj = 0; bj < 2; ++bj) { gw[mm][bj] = *(const u32x4*)(gate + gate_off(row0 + ai * 128 + (4 * mh + mm) * 16, col0 + bj * 128));
                        if (PASS == 1) pw[mm][bj] = *(const u32x4*)(Mo + (size_t)(row0 + ai * 128 + (4 * mh + mm) * 16) * 1024 + col0 + bj * 128); }
#pragma unroll
                for (int mm = 0; mm < 4; ++mm) { const int m = 4 * mh + mm; const size_t ro = (size_t)(row0 + ai * 128 + m * 16) * 1024 + col0;
#pragma unroll
                    for (int bj = 0; bj < 2; ++bj) { const u32x4 g4 = gw[mm][bj];
                        float v[8];
                        v[0] = acc[ai][bj][m][0][0] * bf_lo(g4.x); v[1] = acc[ai][bj][m][0][1] * bf_hi(g4.x); v[2] = acc[ai][bj][m][0][2] * bf_lo(g4.y); v[3] = acc[ai][bj][m][0][3] * bf_hi(g4.y);
                        v[4] = acc[ai][bj][m][1][0] * bf_lo(g4.z); v[5] = acc[ai][bj][m][1][1] * bf_hi(g4.z); v[6] = acc[ai][bj][m][1][2] * bf_lo(g4.w); v[7] = acc[ai][bj][m][1][3] * bf_hi(g4.w);
                        if (PASS == 1) { const u32x4 p4 = pw[mm][bj];
                            v[0] += bf_lo(p4.x); v[1] += bf_hi(p4.x); v[2] += bf_lo(p4.y); v[3] += bf_hi(p4.y); v[4] += bf_lo(p4.z); v[5] += bf_hi(p4.z); v[6] += bf_lo(p4.w); v[7] += bf_hi(p4.w); }
                        u32x4 w; w.x = pk2(v[0], v[1]); w.y = pk2(v[2], v[3]); w.z = pk2(v[4], v[5]); w.w = pk2(v[6], v[7]);
                        *(u32x4*)(Mo + ro + bj * 128) = w; } }
            }
    }
};
struct EpiResid {
    static constexpr bool PERM = false, AFTER_DRAIN = false;
    const float* x; float* out; const float* mod;
    __device__ __forceinline__ void operator()(const pg8::f32x4 (&acc)[2][2][4][2], const pg8::Unit& u, int wr, int wc, int fr, int fq) const {
        int fro = fr; asm volatile("" : "+v"(fro));
        const int row0 = u.pm * 256 + wr * 64 + fro, col0 = u.pn * 256 + wc * 32 + 4 * fq;
        const int b = (u.pm * 256) >> 13;
        f32x4 gv[2][2];
#pragma unroll
        for (int bj = 0; bj < 2; ++bj)
#pragma unroll
            for (int n = 0; n < 2; ++n) gv[bj][n] = *(const f32x4*)(mod + b * 6144 + 2048 + col0 + bj * 128 + n * 16);
#pragma unroll
        for (int ai = 0; ai < 2; ++ai)
#pragma unroll
            for (int mh = 0; mh < 2; ++mh) {
                f32x4 xv[2][2][2];
#pragma unroll
                for (int mm = 0; mm < 2; ++mm)
#pragma unroll
                    for (int bj = 0; bj < 2; ++bj)
#pragma unroll
                        for (int n = 0; n < 2; ++n) xv[mm][bj][n] = *(const f32x4*)(x + (size_t)(row0 + ai * 128 + (2 * mh + mm) * 16) * 1024 + col0 + bj * 128 + n * 16);
#pragma unroll
                for (int mm = 0; mm < 2; ++mm) { const int m = 2 * mh + mm; const size_t ro = (size_t)(row0 + ai * 128 + m * 16) * 1024 + col0;
#pragma unroll
                    for (int bj = 0; bj < 2; ++bj)
#pragma unroll
                        for (int n = 0; n < 2; ++n) *(f32x4*)(out + ro + bj * 128 + n * 16) = xv[mm][bj][n] + gv[bj][n] * acc[ai][bj][m][n]; }
            }
    }
};

__device__ __forceinline__ void unpack8(const u32x4 v, float (&o)[8]);
typedef u32x4 frag_t;
__device__ __forceinline__ bf16x8 asbf(frag_t f) { return __builtin_bit_cast(bf16x8, f); }
__device__ __forceinline__ frag_t fneg(frag_t f) { return f ^ 0x80008000u; }
__device__ __forceinline__ unsigned xs_off(int row, int col) { return (unsigned)(row * 256 + ((((col >> 3) ^ ((row ^ (row >> 3)) & 15))) << 4) + ((col & 7) << 1)); }
#define MFMA16(a, b, c) __builtin_amdgcn_mfma_f32_16x16x32_bf16(asbf(a), asbf(b), c, 0, 0, 0)
constexpr int FFT_FP_RE = 0, FFT_FP_IM = 32768, FFT_XS = 65536, FFT_VB_RE = 98304, FFT_VB_IM = 131072;

__device__ __forceinline__ void fft_load_tables(const Params& p, LAS unsigned char* lds, int tid) {
    const u32x4* src = (const u32x4*)(p.ws + WS_FPIMG);
#pragma unroll
    for (int k = 0; k < 8; ++k) *(LAS u32x4*)(lds + FFT_FP_RE + (tid + 512 * k) * 16) = src[tid + 512 * k];
}
__device__ __forceinline__ void ph3a_filter_spectrum(const int wv, const Params& p, unsigned char* smem) {
    const int tid = opaque_tid(wv), lane = tid & 63, w = __builtin_amdgcn_readfirstlane(tid >> 6), r16 = lane & 15, q = lane >> 4;
    LAS unsigned char* lds = (LAS unsigned char*)smem;
    unsigned char* ws = p.ws;
    const bf16* kern2 = (const bf16*)(ws + WS_KERN2); const float* kpart = (const float*)(ws + WS_KPART2);
    float* hbuf = (float*)(ws + WS_HBUF);
    LAS float* red = (LAS float*)(lds + FFT_VB_RE);
    fft_load_tables(p, lds, tid);
    const int k1 = 16 * w + r16;
    unsigned fo[4];
#pragma unroll
    for (int ks_ = 0; ks_ < 4; ++ks_) fo[ks_] = (unsigned)(r16 * 256 + ((((4 * ks_ + q) ^ ((r16 ^ (r16 >> 3)) & 15))) << 4));
    frag_t Bre[4], Bim[4];
    { const bf16* fn = (const bf16*)(ws + WS_FNAT);
#pragma unroll
      for (int ks_ = 0; ks_ < 4; ++ks_) { Bre[ks_] = *(const frag_t*)(fn + k1 * 128 + 32 * ks_ + 8 * q); Bim[ks_] = *(const frag_t*)(fn + 16384 + k1 * 128 + 32 * ks_ + 8 * q); } }
    float cb[4], sb[4], cd, sd;
#pragma unroll
    for (int r = 0; r < 4; ++r) sincos_f(3.8349519697141029e-4f * (float)(k1 * (4 * q + r)), sb[r], cb[r]);
    sincos_f(3.8349519697141029e-4f * (float)(k1 * 16), sd, cd);
    const int cper = (1024 + (int)gridDim.x - 1) / (int)gridDim.x;
    for (int c = blockIdx.x * cper; c < min(1024, ((int)blockIdx.x + 1) * cper); ++c) {
        __syncthreads();
        float pv = kpart[(tid >> 1) * 2048 + (tid & 1) * 1024 + c] + kpart[((tid >> 1) + 256) * 2048 + (tid & 1) * 1024 + c];
        pv = wave_sum(pv);
        if (lane == 0) red[w] = pv;
        const bf16* kr = kern2 + (size_t)c * 16384;
#pragma unroll
        for (int k = 0; k < 4; ++k) { const int pc = tid + 512 * k;
            const u32x4 a = *(const u32x4*)(kr + 8 * pc);
            const unsigned v[8] = {a.x & 0xffffu, a.x >> 16, a.y & 0xffffu, a.y >> 16, a.z & 0xffffu, a.z >> 16, a.w & 0xffffu, a.w >> 16};
#pragma unroll
            for (int e = 0; e < 8; ++e) { const int i2 = 8 * pc + e; const int n = i2 < 8192 ? i2 : ((16384 - (i2 - 8192)) & 16383);
                const bool skip0 = (i2 == 8192);
                const int nn = skip0 ? 8192 : n;
                *(LAS bf16*)(lds + FFT_XS + xs_off(nn & 127, nn >> 7)) = skip0 ? (bf16)0 : (bf16)v[e]; } }
        __syncthreads();
        float tot = 0.f;
#pragma unroll
        for (int ww = 0; ww < 8; ++ww) tot += red[ww];
        const float inv = 1.0f / (tot + EPSF);
        const float skip = p.in[I_HBIAS][c];
        frag_t Yb_re[4], Yb_im[4];
        { float cc[4], ss[4];
#pragma unroll
          for (int r = 0; r < 4; ++r) { cc[r] = cb[r]; ss[r] = sb[r]; }
          unsigned lre0 = 0, lre1 = 0, lim0 = 0, lim1 = 0;
#pragma unroll
          for (int rt = 0; rt < 8; ++rt) {
              unsigned xr = (unsigned)((rt & 7) << 5); asm volatile("" : "+s"(xr));
              f32x4 Yre = (f32x4){0.f, 0.f, 0.f, 0.f}, Yim = (f32x4){0.f, 0.f, 0.f, 0.f};
#pragma unroll
              for (int ks_ = 0; ks_ < 4; ++ks_) { const frag_t A = *(const LAS frag_t*)(lds + FFT_XS + rt * 4096 + (fo[ks_] ^ xr));
                  Yre = MFMA16(A, Bre[ks_], Yre); Yim = MFMA16(A, Bim[ks_], Yim); }
              float pr[4], pi[4];
#pragma unroll
              for (int r = 0; r < 4; ++r) { pr[r] = Yre[r] * cc[r] + Yim[r] * ss[r]; pi[r] = Yim[r] * cc[r] - Yre[r] * ss[r];
                  const float cn = cc[r] * cd - ss[r] * sd, sn = ss[r] * cd + cc[r] * sd; cc[r] = cn; ss[r] = sn; }
              if ((rt & 1) == 0) { lre0 = pk2(pr[0], pr[1]); lre1 = pk2(pr[2], pr[3]); lim0 = pk2(pi[0], pi[1]); lim1 = pk2(pi[2], pi[3]); }
              else { Yb_re[rt >> 1] = (frag_t){lre0, lre1, pk2(pr[0], pr[1]), pk2(pr[2], pr[3])}; Yb_im[rt >> 1] = (frag_t){lim0, lim1, pk2(pi[0], pi[1]), pk2(pi[2], pi[3])}; }
          } }
        float* hc = hbuf + (size_t)c * 32768 + (size_t)w * 4096;
#pragma unroll
        for (int rt = 0; rt < 8; ++rt) {
            unsigned xr = (unsigned)((rt & 7) << 5); asm volatile("" : "+s"(xr));
            f32x4 Xre = (f32x4){0.f, 0.f, 0.f, 0.f}, Xim = (f32x4){0.f, 0.f, 0.f, 0.f};
#pragma unroll
            for (int ks_ = 0; ks_ < 4; ++ks_) { const frag_t Ar = *(const LAS frag_t*)(lds + FFT_FP_RE + rt * 4096 + (fo[ks_] ^ xr)), Ai = *(const LAS frag_t*)(lds + FFT_FP_IM + rt * 4096 + (fo[ks_] ^ xr));
                Xre = MFMA16(Ar, Yb_re[ks_], Xre); Xre = MFMA16(Ai, fneg(Yb_im[ks_]), Xre); Xim = MFMA16(Ar, Yb_im[ks_], Xim); Xim = MFMA16(Ai, Yb_re[ks_], Xim); }
            const float sc = inv * (1.0f / 16384.0f), sk = skip * (1.0f / 16384.0f);
            *(f32x4*)(hc + (rt * 2 + 0) * 256 + lane * 4) = Xre * sc + sk;
            *(f32x4*)(hc + (rt * 2 + 1) * 256 + lane * 4) = Xim * sc;
        }
    }
    __syncthreads();
}
struct RawPiece { u32x4 x1d, vd; unsigned x1e, ve; };
__device__ __forceinline__ void conv_taps8(const u32x4 d, unsigned ed, float w0, float w1, float w2, float bias, float (&o)[8]) {
    float e[10];
    e[0] = bf_lo(ed); e[9] = bf_hi(ed);
    e[1] = bf_lo(d.x); e[2] = bf_hi(d.x); e[3] = bf_lo(d.y); e[4] = bf_hi(d.y); e[5] = bf_lo(d.z); e[6] = bf_hi(d.z); e[7] = bf_lo(d.w); e[8] = bf_hi(d.w);
#pragma unroll
    for (int a = 0; a < 8; ++a) o[a] = (w0 * e[a] + w1 * e[a + 1]) + (w2 * e[a + 2] + bias);
}
__device__ __forceinline__ void ph3b_hyena_fftconv(const int wv, const Params& p, unsigned char* smem) {
    const int tid = opaque_tid(wv), lane = tid & 63, w = __builtin_amdgcn_readfirstlane(tid >> 6), r16 = lane & 15, q = lane >> 4;
    LAS unsigned char* lds = (LAS unsigned char*)smem;
    unsigned char* ws = p.ws;
    const bf16* zT = (const bf16*)(ws + WS_ZT);
    bf16* yhT = (bf16*)(ws + WS_YHT);
    const float* hbuf = (const float*)(ws + WS_HBUF);
    const float* cw = p.in[I_HCW]; const float* cbias = p.in[I_HCB];
    __syncthreads();
    fft_load_tables(p, lds, tid);
    const int k1 = 16 * w + r16;
    frag_t Bre[2], Bim[2];
    { const bf16* fn = (const bf16*)(ws + WS_FNAT);
#pragma unroll
      for (int ks_ = 0; ks_ < 2; ++ks_) { Bre[ks_] = *(const frag_t*)(fn + k1 * 128 + 32 * ks_ + 8 * q); Bim[ks_] = *(const frag_t*)(fn + 16384 + k1 * 128 + 32 * ks_ + 8 * q); } }
    float cb[4], sb[4], cd, sd;
#pragma unroll
    for (int r = 0; r < 4; ++r) sincos_f(3.8349519697141029e-4f * (float)(k1 * (4 * q + r)), sb[r], cb[r]);
    sincos_f(3.8349519697141029e-4f * (float)(k1 * 16), sd, cd);
    const int vpos = 32 * (w >> 1) + 8 * (r16 >> 2) + 4 * (w & 1) + (r16 & 3);
    unsigned fo[4], foi[2];
#pragma unroll
    for (int ks_ = 0; ks_ < 4; ++ks_) fo[ks_] = (unsigned)(r16 * 256 + ((((4 * ks_ + q) ^ ((r16 ^ (r16 >> 3)) & 15))) << 4));
#pragma unroll
    for (int ks_ = 0; ks_ < 2; ++ks_) foi[ks_] = (unsigned)(r16 * 256 + ((((8 + 4 * ks_ + q) ^ ((r16 ^ (r16 >> 3)) & 15))) << 4));
    const int nseq = 4096, per = __builtin_amdgcn_readfirstlane((int)((nseq + gridDim.x - 1) / gridDim.x));
    const int sq0 = __builtin_amdgcn_readfirstlane((int)(blockIdx.x * per)), sq1 = __builtin_amdgcn_readfirstlane(min(nseq, sq0 + per));
#define FFT_RAW_LOAD(sq_) do { const int c_ = (sq_) >> 2, bp_ = (sq_) & 3; \
        const bf16* x1u = zT + ((size_t)((1 * NB + 2 * bp_) * 1024 + c_)) * SEQ; const bf16* vu = zT + ((size_t)((2 * NB + 2 * bp_) * 1024 + c_)) * SEQ;     \
        int tl_ = tid; asm volatile("" : "+v"(tl_)); \
        _Pragma("unroll") for (int k = 0; k < 4; ++k) { const int pc = tl_ + 512 * k, sel = pc >> 10, idx = pc & 1023; const unsigned po = (unsigned)(sel * 1024 * SEQ + 8 * idx); \
            raw[k].x1d = *(const u32x4*)(x1u + po); raw[k].vd = *(const u32x4*)(vu + po); \
            const unsigned pm = idx > 0 ? po - 1u : po, pp = idx < 1023 ? po + 8u : po; \
            const unsigned xa = idx > 0 ? (unsigned)x1u[pm] : 0u, xb = idx < 1023 ? (unsigned)x1u[pp] : 0u, va = idx > 0 ? (unsigned)vu[pm] : 0u, vb = idx < 1023 ? (unsigned)vu[pp] : 0u; \
            raw[k].x1e = xa | (xb << 16); raw[k].ve = va | (vb << 16); } } while (0)
#define FFT_RAW_STAGE(sq_) do { const int c_ = (sq_) >> 2; \
        const float x1w0 = cw[1024 + c_], x1w1 = cw[3072 + 1024 + c_], x1w2 = cw[6144 + 1024 + c_], x1b = cbias[1024 + c_]; \
        const float vw0 = cw[2048 + c_], vw1 = cw[3072 + 2048 + c_], vw2 = cw[6144 + 2048 + c_], vb_ = cbias[2048 + c_]; \
        int tt_ = tid; asm volatile("" : "+v"(tt_)); \
        _Pragma("unroll") for (int k = 0; k < 4; ++k) { const int pc = tt_ + 512 * k, sel = pc >> 10, idx = pc & 1023; const int n1 = idx >> 4, n20 = (idx & 15) * 8; \
            float a1[8], a2[8]; conv_taps8(raw[k].x1d, raw[k].x1e, x1w0, x1w1, x1w2, x1b, a1); conv_taps8(raw[k].vd, raw[k].ve, vw0, vw1, vw2, vb_, a2); \
            _Pragma("unroll") for (int e = 0; e < 8; ++e) *(LAS bf16*)(lds + FFT_XS + xs_off(n20 + e, n1 + 64 * sel)) = (bf16)f2bf(a1[e] * a2[e]); } } while (0)
    if (sq0 < sq1) { RawPiece raw[4]; FFT_RAW_LOAD(sq0); FFT_RAW_STAGE(sq0); }
    __syncthreads();
    for (int sq = sq0; sq < sq1; ++sq) {
        const int sqn = min(sq + 1, sq1 - 1);
        RawPiece raw[4]; FFT_RAW_LOAD(sqn);
        SEC_BEGIN(2);
        frag_t Yb_re[4], Yb_im[4];
        { float cc[4], ss[4];
#pragma unroll
          for (int r = 0; r < 4; ++r) { cc[r] = cb[r]; ss[r] = sb[r]; }
          unsigned lre0 = 0, lre1 = 0, lim0 = 0, lim1 = 0;
#pragma unroll
          for (int rt = 0; rt < 8; ++rt) {
              asm volatile("" ::: "memory");
              unsigned xr = (unsigned)((rt & 7) << 5); asm volatile("" : "+s"(xr));
              f32x4 Yre = (f32x4){0.f, 0.f, 0.f, 0.f}, Yim = (f32x4){0.f, 0.f, 0.f, 0.f};
#pragma unroll
              for (int ks_ = 0; ks_ < 2; ++ks_) { const frag_t Ar = *(const LAS frag_t*)(lds + FFT_XS + rt * 4096 + (fo[ks_] ^ xr)), Ai = *(const LAS frag_t*)(lds + FFT_XS + rt * 4096 + (foi[ks_] ^ xr));
                  Yre = MFMA16(Ar, Bre[ks_], Yre); Yre = MFMA16(Ai, fneg(Bim[ks_]), Yre); Yim = MFMA16(Ar, Bim[ks_], Yim); Yim = MFMA16(Ai, Bre[ks_], Yim); }
              float pr[4], pi[4];
#pragma unroll
              for (int r = 0; r < 4; ++r) { pr[r] = Yre[r] * cc[r] + Yim[r] * ss[r]; pi[r] = Yim[r] * cc[r] - Yre[r] * ss[r];
                  const float cn = cc[r] * cd - ss[r] * sd, sn = ss[r] * cd + cc[r] * sd; cc[r] = cn; ss[r] = sn; }
              if ((rt & 1) == 0) { lre0 = pk2(pr[0], pr[1]); lre1 = pk2(pr[2], pr[3]); lim0 = pk2(pi[0], pi[1]); lim1 = pk2(pi[2], pi[3]); }
              else { Yb_re[rt >> 1] = (frag_t){lre0, lre1, pk2(pr[0], pr[1]), pk2(pr[2], pr[3])}; Yb_im[rt >> 1] = (frag_t){lim0, lim1, pk2(pi[0], pi[1]), pk2(pi[2], pi[3])}; }
          } }
        SEC_END(2, ws); SEC_BEGIN(3); SEC_BEGIN(8);
        __syncthreads();
        FFT_RAW_STAGE(sqn);
        SEC_END(8, ws); SEC_BEGIN(9);
        frag_t Zb_re[4], Zb_im[4];
        { int sqc = sq; asm volatile("" : "+s"(sqc));
          const float* hc = hbuf + (size_t)(sqc >> 2) * 32768 + (size_t)w * 4096;
          unsigned lre0 = 0, lre1 = 0, lim0 = 0, lim1 = 0;
          f32x4 Hrn = *(const f32x4*)(hc + lane * 4), Hin = *(const f32x4*)(hc + 256 + lane * 4);
#pragma unroll
          for (int rt = 0; rt < 8; ++rt) {
              asm volatile("" ::: "memory");
              unsigned xr = (unsigned)((rt & 7) << 5); asm volatile("" : "+s"(xr));
              const f32x4 Hr = Hrn, Hi = Hin;
              if (rt < 7) { Hrn = *(const f32x4*)(hc + ((rt + 1) * 2 + 0) * 256 + lane * 4); Hin = *(const f32x4*)(hc + ((rt + 1) * 2 + 1) * 256 + lane * 4); }
              f32x4 Xre = (f32x4){0.f, 0.f, 0.f, 0.f}, Xim = (f32x4){0.f, 0.f, 0.f, 0.f};
#pragma unroll
              for (int ks_ = 0; ks_ < 4; ++ks_) { const frag_t Ar = *(const LAS frag_t*)(lds + FFT_FP_RE + rt * 4096 + (fo[ks_] ^ xr)), Ai = *(const LAS frag_t*)(lds + FFT_FP_IM + rt * 4096 + (fo[ks_] ^ xr));
                  Xre = MFMA16(Ar, Yb_re[ks_], Xre); Xre = MFMA16(Ai, fneg(Yb_im[ks_]), Xre); Xim = MFMA16(Ar, Yb_im[ks_], Xim); Xim = MFMA16(Ai, Yb_re[ks_], Xim); }
              const f32x4 zr = Xre * Hr - Xim * Hi, zi = Xre * Hi + Xim * Hr;
              if ((rt & 1) == 0) { lre0 = pk2(zr[0], zr[1]); lre1 = pk2(zr[2], zr[3]); lim0 = pk2(zi[0], zi[1]); lim1 = pk2(zi[2], zi[3]); }
              else { Zb_re[rt >> 1] = (frag_t){lre0, lre1, pk2(zr[0], zr[1]), pk2(zr[2], zr[3])}; Zb_im[rt >> 1] = (frag_t){lim0, lim1, pk2(zi[0], zi[1]), pk2(zi[2], zi[3])}; }
          } }
        SEC_END(9, ws); SEC_BEGIN(10);
        { float cc[4], ss[4];
#pragma unroll
          for (int r = 0; r < 4; ++r) { cc[r] = cb[r]; ss[r] = sb[r]; }
          unsigned vo[4];
          { int q4 = 4 * q; asm volatile("" : "+v"(q4));
#pragma unroll
            for (int r = 0; r < 4; ++r) { const int x_ = q4 + r; vo[r] = (unsigned)(x_ * 256 + ((((vpos >> 3) ^ ((x_ ^ (x_ >> 3)) & 15))) << 4) + ((vpos & 7) << 1)); } }
#pragma unroll
          for (int rt = 0; rt < 8; ++rt) {
              asm volatile("" ::: "memory");
              unsigned xr = (unsigned)((rt & 7) << 5); asm volatile("" : "+s"(xr));
              f32x4 Vre = (f32x4){0.f, 0.f, 0.f, 0.f}, Vim = (f32x4){0.f, 0.f, 0.f, 0.f};
#pragma unroll
              for (int ks_ = 0; ks_ < 4; ++ks_) { const frag_t Ar = *(const LAS frag_t*)(lds + FFT_FP_RE + rt * 4096 + (fo[ks_] ^ xr)), Ai = *(const LAS frag_t*)(lds + FFT_FP_IM + rt * 4096 + (fo[ks_] ^ xr));
                  Vre = MFMA16(Ar, Zb_re[ks_], Vre); Vre = MFMA16(Ai, Zb_im[ks_], Vre); Vim = MFMA16(Ar, Zb_im[ks_], Vim); Vim = MFMA16(Ai, fneg(Zb_re[ks_]), Vim); }
#pragma unroll
              for (int r = 0; r < 4; ++r) { const float pr = Vre[r] * cc[r] - Vim[r] * ss[r], pi = Vim[r] * cc[r] + Vre[r] * ss[r];
                  const float cn = cc[r] * cd - ss[r] * sd, sn = ss[r] * cd + cc[r] * sd; cc[r] = cn; ss[r] = sn;
                  const unsigned off = rt * 4096 + (vo[r] ^ xr);
                  *(LAS bf16*)(lds + FFT_VB_RE + off) = (bf16)f2bf(pr); *(LAS bf16*)(lds + FFT_VB_IM + off) = (bf16)f2bf(pi); }
          } }
        __syncthreads();
        SEC_END(3, ws); SEC_END(10, ws); SEC_BEGIN(4);
        { frag_t Vr[4], Vi[4];
#pragma unroll
          for (int ks_ = 0; ks_ < 4; ++ks_) { Vr[ks_] = *(const LAS frag_t*)(lds + FFT_VB_RE + w * 4096 + (fo[ks_] ^ ((w & 7) << 5))); Vi[ks_] = *(const LAS frag_t*)(lds + FFT_VB_IM + w * 4096 + (fo[ks_] ^ ((w & 7) << 5))); }
          int sqe = sq; asm volatile("" : "+s"(sqe));
          const int c = sqe >> 2, bp = sqe & 3;
          u32x4 x0d[4]; unsigned x0e[4];
          { const bf16* x0u = zT + ((size_t)((0 * NB + 2 * bp) * 1024 + c)) * SEQ;
            int tl_ = tid; asm volatile("" : "+v"(tl_));
#pragma unroll
            for (int k = 0; k < 4; ++k) { const int pc = tl_ + 512 * k, sel = pc >> 10, idx = pc & 1023; const unsigned po = (unsigned)(sel * 1024 * SEQ + 8 * idx);
                x0d[k] = *(const u32x4*)(x0u + po);
                const unsigned pm = idx > 0 ? po - 1u : po, pp = idx < 1023 ? po + 8u : po;
                const unsigned xa = idx > 0 ? (unsigned)x0u[pm] : 0u, xb = idx < 1023 ? (unsigned)x0u[pp] : 0u;
                x0e[k] = xa | (xb << 16); } }
          asm volatile("s_waitcnt lgkmcnt(0)" ::: "memory");
          __syncthreads();
          int tbase = 512 * q + 16 * w + r16; asm volatile("" : "+v"(tbase));
#pragma unroll
          for (int rt = 0; rt < 4; ++rt) {
              asm volatile("" ::: "memory");
              unsigned xr = (unsigned)((rt & 7) << 5); asm volatile("" : "+s"(xr));
              f32x4 yre = (f32x4){0.f, 0.f, 0.f, 0.f}, yim = (f32x4){0.f, 0.f, 0.f, 0.f};
#pragma unroll
              for (int ks_ = 0; ks_ < 4; ++ks_) { const frag_t Ar = *(const LAS frag_t*)(lds + FFT_FP_RE + rt * 4096 + (fo[ks_] ^ xr)), Ai = *(const LAS frag_t*)(lds + FFT_FP_IM + rt * 4096 + (fo[ks_] ^ xr));
                  yre = MFMA16(Ar, Vr[ks_], yre); yre = MFMA16(Ai, Vi[ks_], yre); yim = MFMA16(Ar, Vi[ks_], yim); yim = MFMA16(Ai, fneg(Vr[ks_]), yim); }
#pragma unroll
              for (int r = 0; r < 4; ++r) { const int t = tbase + 128 * (16 * rt + r);
                  *(LAS bf16*)(lds + FFT_VB_RE + 2 * t) = (bf16)f2bf(yre[r]); *(LAS bf16*)(lds + FFT_VB_RE + 16384 + 2 * t) = (bf16)f2bf(yim[r]); }
          }
          asm volatile("s_waitcnt lgkmcnt(0)" ::: "memory");
          __syncthreads();
          const float x0w0 = cw[c], x0w1 = cw[3072 + c], x0w2 = cw[6144 + c], x0b = cbias[c];
          bf16* ou = yhT + ((size_t)((2 * bp) * 1024 + c)) * SEQ;
          { int tl_ = tid; asm volatile("" : "+v"(tl_));
#pragma unroll
            for (int k = 0; k < 4; ++k) { const int pc = tl_ + 512 * k, sel = pc >> 10, idx = pc & 1023; const unsigned po = (unsigned)(sel * 1024 * SEQ + 8 * idx);
                float xc[8]; conv_taps8(x0d[k], x0e[k], x0w0, x0w1, x0w2, x0b, xc);
                const u32x4 yv = *(const LAS u32x4*)(lds + FFT_VB_RE + sel * 16384 + 16 * idx);
                float yy[8]; unpack8(yv, yy);
                u32x4 o; o.x = pk2(yy[0] * xc[0], yy[1] * xc[1]); o.y = pk2(yy[2] * xc[2], yy[3] * xc[3]); o.z = pk2(yy[4] * xc[4], yy[5] * xc[5]); o.w = pk2(yy[6] * xc[6], yy[7] * xc[7]);
                *(u32x4*)(ou + po) = o; } }
        }
        SEC_END(4, ws);
    }
#undef FFT_RAW_LOAD
#undef FFT_RAW_STAGE
    __syncthreads();
}

__device__ __forceinline__ bf16x8 mk8(unsigned a, unsigned b, unsigned c, unsigned d) { u32x4 t = {a, b, c, d}; return __builtin_bit_cast(bf16x8, t); }
#ifndef RET_SBM
#define RET_SBM 0
#endif
#define RET_SB1 do { if (RET_SBM & 1) __builtin_amdgcn_sched_barrier(0); } while (0)
#define RET_SB2 do { if (RET_SBM & 2) __builtin_amdgcn_sched_barrier(0); } while (0)
#define RET_SB3 do { if (RET_SBM & 4) __builtin_amdgcn_sched_barrier(0); } while (0)
__device__ __forceinline__ void ph4_retention(const int wv, const Params& p, unsigned char* smem) {
    constexpr int PK = 136;
#define KT_OFF(d_, j_) ((d_) * PK + (((((j_) >> 3) ^ (((d_) >> 3) & 15)) << 3) | ((j_) & 7)))
#define VT_OFF(v_, j_) ((v_) * PK + (((((j_) >> 3) ^ (((v_) >> 3) & 7)) << 3) | ((j_) & 7)))
    const int tid = opaque_tid(wv), lane = tid & 63, w = __builtin_amdgcn_readfirstlane(tid >> 6), r16 = lane & 15, q = lane >> 4;
    unsigned char* ws = p.ws;
    LAS unsigned char* lds = (LAS unsigned char*)smem;
    LAS bf16* Ks = (LAS bf16*)lds;
    LAS bf16* KTs = (LAS bf16*)(lds + 34816);
    LAS bf16* VTs = (LAS bf16*)(lds + 69632);
    LAS bf16* STs = (LAS bf16*)(lds + 87040);
    const bf16* QKb = (const bf16*)(ws + WS_QK); const bf16* Vb = (const bf16*)(ws + WS_V);
    const bf16* CKb = (const bf16*)(ws + WS_CK); const bf16* CVb = (const bf16*)(ws + WS_CV);
    for (int un0 = blockIdx.x; un0 < 256; un0 += gridDim.x) {
        const int un = (gridDim.x == 256) ? ((((un0 & 7) * 4 + (un0 >> 6)) << 3) | ((un0 >> 3) & 7)) : un0;
        const int b = un >> 5, h = (un >> 3) & 3, dir = (un >> 2) & 1, vs = un & 3;
        const float lg2 = (dir ? p.in[I_LGB] : p.in[I_LGF])[h] * 1.4426950408889634f;
        const float gC = exp2f(lg2 * 128.0f);
        bf16* Odst = (bf16*)(ws + (dir ? WS_OB : WS_OF));
        const int kj = tid >> 4, kcq = tid & 15;
        const int vj = tid >> 3, vcq = tid & 7;
        float zeta[4];
#pragma unroll
        for (int k = 0; k < 4; ++k) { const int j = kj + 32 * k; zeta[k] = exp2f(lg2 * (float)(dir ? j : 127 - j)); }
        float xil;
        { const int i = 16 * w + r16; xil = exp2f(lg2 * (float)((dir ? 127 - i : i) + 1)); }
        const float sgf = dir ? -1.0f : 1.0f;
        int tr[4]; float pr[4];
        { int il = 16 * w + r16; asm volatile("" : "+v"(il));
#pragma unroll
          for (int r = 0; r < 4; ++r) { tr[r] = il - 4 * q - r; pr[r] = exp2f(lg2 * sgf * (float)tr[r]); } }
        float scs[8];
#pragma unroll
        for (int e = 0; e < 8; ++e) scs[e] = __int_as_float(__builtin_amdgcn_readfirstlane(__float_as_int(exp2f(-lg2 * sgf * (float)(16 * e)))));
        f32x4 Sacc[4];
#pragma unroll
        for (int vt = 0; vt < 4; ++vt) Sacc[vt] = (f32x4){0.f, 0.f, 0.f, 0.f};
        u32x4 kreg[4], vreg[2]; bf16x8 qf[4];
#pragma unroll
        for (int k = 0; k < 4; ++k) qf[k] = mk8(0, 0, 0, 0);
#define RET_LOAD(st_) do { const int s_ = (st_); \
            if (s_ < 2) { const int ci = dir ? 1 - s_ : s_; const size_t tok0 = (size_t)b * 256 + ci * 128; \
                const bf16* Kp = CKb + tok0 * 512 + h * 128; const bf16* Vp = CVb + tok0 * 1024 + h * 256 + vs * 64; \
                _Pragma("unroll") for (int k = 0; k < 4; ++k) kreg[k] = *(const u32x4*)(Kp + (size_t)(kj + 32 * k) * 512 + 8 * kcq); \
                _Pragma("unroll") for (int k = 0; k < 2; ++k) vreg[k] = *(const u32x4*)(Vp + (size_t)(vj + 64 * k) * 1024 + 8 * vcq); \
            } else { const int n = dir ? 63 - (s_ - 2) : s_ - 2; const size_t tok0 = (size_t)b * SEQ + n * 128; \
                const bf16* Kp = QKb + tok0 * 1024 + 512 + h * 128; const bf16* Vp = Vb + tok0 * 1024 + h * 256 + vs * 64; \
                _Pragma("unroll") for (int k = 0; k < 4; ++k) kreg[k] = *(const u32x4*)(Kp + (size_t)(kj + 32 * k) * 1024 + 8 * kcq); \
                _Pragma("unroll") for (int k = 0; k < 2; ++k) vreg[k] = *(const u32x4*)(Vp + (size_t)(vj + 64 * k) * 1024 + 8 * vcq); \
            } } while (0)
        RET_LOAD(0);
        for (int st = 0; st < 66; ++st) {
            if (st >= 2) { const int n = dir ? 63 - (st - 2) : st - 2; const bf16* Qp = QKb + ((size_t)b * SEQ + n * 128) * 1024 + h * 128;
#pragma unroll
                for (int k = 0; k < 4; ++k) qf[k] = *(const bf16x8*)(Qp + (size_t)(16 * w + r16) * 1024 + 32 * k + 8 * q); }
            SEC_BEGIN(5); SEC_BEGIN(12);
            __syncthreads();
            SEC_END(12, ws); SEC_BEGIN(13);
#pragma unroll
            for (int k = 0; k < 4; ++k) { const int j = kj + 32 * k; *(LAS u32x4*)(Ks + j * PK + 8 * kcq) = kreg[k];
                const unsigned wv[4] = {kreg[k].x, kreg[k].y, kreg[k].z, kreg[k].w};
#pragma unroll
                for (int e2 = 0; e2 < 4; ++e2) { KTs[KT_OFF(8 * kcq + 2 * e2, j)] = (bf16)f2bf(bf_lo(wv[e2]) * zeta[k]); KTs[KT_OFF(8 * kcq + 2 * e2 + 1, j)] = (bf16)f2bf(bf_hi(wv[e2]) * zeta[k]); } }
#pragma unroll
            for (int k = 0; k < 2; ++k) { const int j = vj + 64 * k; const unsigned wv[4] = {vreg[k].x, vreg[k].y, vreg[k].z, vreg[k].w};
#pragma unroll
                for (int e2 = 0; e2 < 4; ++e2) { VTs[VT_OFF(8 * vcq + 2 * e2, j)] = (bf16)(wv[e2] & 0xffffu); VTs[VT_OFF(8 * vcq + 2 * e2 + 1, j)] = (bf16)(wv[e2] >> 16); } }
#pragma unroll
            for (int vt = 0; vt < 4; ++vt) { u32x2 sv; sv.x = pk2(Sacc[vt][0], Sacc[vt][1]); sv.y = pk2(Sacc[vt][2], Sacc[vt][3]); *(LAS u32x2*)(STs + (16 * vt + r16) * PK + 16 * w + 4 * q) = sv; }
            asm volatile("s_waitcnt lgkmcnt(0)" ::: "memory"); SEC_END(13, ws); SEC_BEGIN(14);
            __syncthreads();
            SEC_END(14, ws); SEC_END(5, ws); SEC_BEGIN(6);
            if (st + 1 < 66) RET_LOAD(st + 1);
            int r16s = r16; asm volatile("" : "+v"(r16s));
            if (st >= 2) {
                const int n = dir ? 63 - (st - 2) : st - 2; const size_t tok0 = (size_t)b * SEQ + n * 128;
                bf16x8 Pf[4];
#pragma unroll
                for (int ks_ = 0; ks_ < 4; ++ks_) {
                    f32x4 Xa = (f32x4){0.f, 0.f, 0.f, 0.f}, Xb = (f32x4){0.f, 0.f, 0.f, 0.f};
#pragma unroll
                    for (int kd = 0; kd < 4; ++kd) { const bf16x8 A0 = *(const LAS bf16x8*)(Ks + (32 * ks_ + r16) * PK + 32 * kd + 8 * q), A1 = *(const LAS bf16x8*)(Ks + (32 * ks_ + 16 + r16) * PK + 32 * kd + 8 * q);
                        Xa = __builtin_amdgcn_mfma_f32_16x16x32_bf16(A0, qf[kd], Xa, 0, 0, 0); Xb = __builtin_amdgcn_mfma_f32_16x16x32_bf16(A1, qf[kd], Xb, 0, 0, 0); }
                    float pv[8];
#pragma unroll
                    for (int r = 0; r < 4; ++r) { const int da = tr[r] - 32 * ks_, db = da - 16; const bool oka = dir ? (da <= 0) : (da >= 0), okb = dir ? (db <= 0) : (db >= 0);
                        pv[r] = oka ? Xa[r] * (pr[r] * scs[2 * ks_]) : 0.f; pv[4 + r] = okb ? Xb[r] * (pr[r] * scs[2 * ks_ + 1]) : 0.f; }
                    Pf[ks_] = mk8(pk2(pv[0], pv[1]), pk2(pv[2], pv[3]), pk2(pv[4], pv[5]), pk2(pv[6], pv[7]));
                    RET_SB1;
                }
#pragma unroll
                for (int vt = 0; vt < 4; ++vt) { f32x4 O = (f32x4){0.f, 0.f, 0.f, 0.f};
#pragma unroll
                    for (int ks_ = 0; ks_ < 4; ++ks_) { const bf16x8 Bq = *(const LAS bf16x8*)(STs + (16 * vt + r16) * PK + 32 * ks_ + 8 * q); O = __builtin_amdgcn_mfma_f32_16x16x32_bf16(Bq, qf[ks_], O, 0, 0, 0); }
#pragma unroll
                    for (int r = 0; r < 4; ++r) O[r] *= xil;
#pragma unroll
                    for (int ks_ = 0; ks_ < 4; ++ks_) { const u32x2 lo = *(const LAS u32x2*)(VTs + VT_OFF(16 * vt + r16s, 32 * ks_ + 4 * q)), hi = *(const LAS u32x2*)(VTs + VT_OFF(16 * vt + r16s, 32 * ks_ + 16 + 4 * q));
                        O = __builtin_amdgcn_mfma_f32_16x16x32_bf16(mk8(lo.x, lo.y, hi.x, hi.y), Pf[ks_], O, 0, 0, 0); }
                    bf16* od = Odst + (tok0 + 16 * w + r16s) * 1024 + h * 256 + vs * 64 + 16 * vt + 4 * q;
                    u32x2 ov; ov.x = pk2(O[0], O[1]); ov.y = pk2(O[2], O[3]);
                    *(u32x2*)od = ov;
                    RET_SB2;
                }
            }
#pragma unroll
            for (int vt = 0; vt < 4; ++vt) { Sacc[vt] = Sacc[vt] * gC;
#pragma unroll
                for (int ks_ = 0; ks_ < 4; ++ks_) { const bf16x8 A = *(const LAS bf16x8*)(KTs + KT_OFF(16 * w + r16s, 32 * ks_ + 8 * q)), Bv = *(const LAS bf16x8*)(VTs + VT_OFF(16 * vt + r16s, 32 * ks_ + 8 * q));
                    Sacc[vt] = __builtin_amdgcn_mfma_f32_16x16x32_bf16(A, Bv, Sacc[vt], 0, 0, 0); }
                RET_SB3; }
            SEC_END(6, ws);
        }
#undef RET_LOAD
#undef KT_OFF
#undef VT_OFF
    }
    __syncthreads();
}
__device__ __forceinline__ void ph4_transpose_yh(const int wv, const Params& p, unsigned char* smem) {
    const int tid = opaque_tid(wv), lane = tid & 63, wave = __builtin_amdgcn_readfirstlane(tid >> 6);
    const int gw = blockIdx.x * 8 + wave, NGW = gridDim.x * 8;
    LAS bf16* tile = (LAS bf16*)((LAS unsigned char*)smem + wave * 8448);
    const bf16* yhT = (const bf16*)(p.ws + WS_YHT); bf16* yh = (bf16*)(p.ws + WS_YH);
    for (int it = gw; it < 16384; it += NGW) {
        const int b = it >> 11, cb = (it >> 7) & 15, tb = it & 127;
        const bf16* src = yhT + ((size_t)(b * 1024 + cb * 64)) * SEQ + tb * 64;
#pragma unroll
        for (int k = 0; k < 8; ++k) { const int pc = lane + 64 * k, row = pc >> 3, ch = pc & 7; const u32x4 v = *(const u32x4*)(src + (size_t)row * SEQ + 8 * ch);
            const unsigned wv[4] = {v.x, v.y, v.z, v.w};
#pragma unroll
            for (int e2 = 0; e2 < 4; ++e2) { tile[(8 * ch + 2 * e2) * 66 + row] = (bf16)(wv[e2] & 0xffffu); tile[(8 * ch + 2 * e2 + 1) * 66 + row] = (bf16)(wv[e2] >> 16); } }
        __builtin_amdgcn_s_waitcnt(0xC07F); asm volatile("" ::: "memory");
        bf16* dst = yh + ((size_t)(b * SEQ + tb * 64)) * 1024 + cb * 64;
#pragma unroll
        for (int k = 0; k < 32; ++k) { const int idx = lane + 64 * k, trow = idx >> 5, cw = idx & 31; const unsigned wd = *(const LAS unsigned*)(tile + trow * 66 + 2 * cw);
            *(unsigned*)(dst + (size_t)trow * 1024 + 2 * cw) = wd; }
        __builtin_amdgcn_s_waitcnt(0xC07F); asm volatile("" ::: "memory");
    }
}

__device__ __forceinline__ void readout_items(const int wv, const Params& p, const int it0, const int it1, const int first, const int stride) {
    const int lane = opaque_tid(wv) & 63;
    bf16* OF = (bf16*)(p.ws + WS_OF); const bf16* OB = (const bf16*)(p.ws + WS_OB); const bf16* G = (const bf16*)(p.ws + WS_G);
    for (int it = it0 + first; it < it1; it += 4 * stride) {
        u32x2 a[4], b[4], g[4]; size_t off[4];
#pragma unroll
        for (int u = 0; u < 4; ++u) { const int itu = min(it + u * stride, it1 - 1); off[u] = (size_t)itu * 256 + 4 * lane; a[u] = *(const u32x2*)(OF + off[u]); b[u] = *(const u32x2*)(OB + off[u]); g[u] = *(const u32x2*)(G + off[u]); }
#pragma unroll
        for (int u = 0; u < 4; ++u) {
            float o[4] = {bf_lo(a[u].x) + bf_lo(b[u].x), bf_hi(a[u].x) + bf_hi(b[u].x), bf_lo(a[u].y) + bf_lo(b[u].y), bf_hi(a[u].y) + bf_hi(b[u].y)};
            float ss = (o[0] * o[0] + o[1] * o[1]) + (o[2] * o[2] + o[3] * o[3]);
            ss = wave_sum_dpp(ss);
            const float rs = 1.0f / sqrtf(ss * (1.0f / 256.0f) + EPSF);
            u32x2 r; r.x = pk2(o[0] * rs * bf_lo(g[u].x), o[1] * rs * bf_hi(g[u].x)); r.y = pk2(o[2] * rs * bf_lo(g[u].y), o[3] * rs * bf_hi(g[u].y));
            if (it + u * stride < it1) *(u32x2*)(OF + off[u]) = r; }
    }
}
__device__ __forceinline__ void convert_expert_tables(const int wv, const Params& p) {
    const int tid = opaque_tid(wv);
    const size_t gt = (size_t)blockIdx.x * NTHR + tid, NGT = (size_t)gridDim.x * NTHR;
    for (size_t i = gt; i < (size_t)2 * 16384 * 64; i += NGT) {
        const size_t tsel = i >> 20, j = i & ((1u << 20) - 1);
        const float* src = (tsel ? p.in[I_PV] : p.in[I_PU]) + j * 16; const float sc = tsel ? 5.0f : 56.0f;
        u32x2 o;
#pragma unroll
        for (int d = 0; d < 2; ++d) { const f32x4 a = *(const f32x4*)(src + 8 * d) * sc, b2 = *(const f32x4*)(src + 8 * d + 4) * sc;
            unsigned w = 0u;
            w = __builtin_amdgcn_cvt_scalef32_pk_fp4_f32(w, a.x, a.y, 1.0f, 0); w = __builtin_amdgcn_cvt_scalef32_pk_fp4_f32(w, a.z, a.w, 1.0f, 1);
            w = __builtin_amdgcn_cvt_scalef32_pk_fp4_f32(w, b2.x, b2.y, 1.0f, 2); w = __builtin_amdgcn_cvt_scalef32_pk_fp4_f32(w, b2.z, b2.w, 1.0f, 3);
            o[d] = w; }
        *(u32x2*)(p.ws + (tsel ? WS_PV : WS_PU) + j * 8) = o;
    }
}

__device__ __forceinline__ void rows2_range(const int wv, const Params& p, const int r0, const int r1) {
    const int tid = opaque_tid(wv), lane = tid & 63, wave = __builtin_amdgcn_readfirstlane(tid >> 6);
    const float* mod = (const float*)(p.ws + WS_MOD);
    const float* md = mod + (r0 >> 13) * 6144;
    f32x4 gsc[4], shv[4];
#pragma unroll
    for (int j = 0; j < 4; ++j) { const int c0 = 4 * lane + 256 * j; gsc[j] = *(const f32x4*)(p.in[I_NORM2] + c0) * (*(const f32x4*)(md + 4096 + c0) + 1.0f); shv[j] = *(const f32x4*)(md + 3072 + c0); }
    f32x4 vn[4];
#pragma unroll
    for (int j = 0; j < 4; ++j) vn[j] = *(const f32x4*)(p.out + (size_t)(r0 + wave) * 1024 + 4 * lane + 256 * j);
    for (int r = r0 + wave; r < r1; r += 8) {
        bf16* dst = (bf16*)(p.ws + WS_H2) + (size_t)r * 1024; unsigned char* dst8 = p.ws + WS_X8 + (size_t)r * 1024;
        f32x4 v[4]; float ss = 0.f;
#pragma unroll
        for (int j = 0; j < 4; ++j) { v[j] = vn[j]; ss += (v[j].x * v[j].x + v[j].y * v[j].y) + (v[j].z * v[j].z + v[j].w * v[j].w); }
        { const int rn = (r + 8 < r1) ? r + 8 : r;
#pragma unroll
          for (int j = 0; j < 4; ++j) vn[j] = *(const f32x4*)(p.out + (size_t)rn * 1024 + 4 * lane + 256 * j); }
        ss = wave_sum_dpp(ss);
        const float rs = 1.0f / sqrtf(ss * (1.0f / 1024.0f) + EPSF);
#pragma unroll
        for (int j = 0; j < 4; ++j) { const int c0 = 4 * lane + 256 * j;
            const f32x4 y = v[j] * rs * gsc[j] + shv[j];
            u32x2 o; o.x = pk2(y.x, y.y); o.y = pk2(y.z, y.w);
            *(u32x2*)(dst + c0) = o;
            const float x0 = bf_lo(o.x) * 1.5f, x1 = bf_hi(o.x) * 1.5f, x2 = bf_lo(o.y) * 1.5f, x3 = bf_hi(o.y) * 1.5f;
            unsigned wh = __builtin_amdgcn_cvt_scalef32_pk_fp4_f32(0u, x0, x1, 1.0f, 0); wh = __builtin_amdgcn_cvt_scalef32_pk_fp4_f32(wh, x2, x3, 1.0f, 1);
            const f32x2 d01 = __builtin_amdgcn_cvt_scalef32_pk_f32_fp4(wh, 1.0f, 0), d23 = __builtin_amdgcn_cvt_scalef32_pk_f32_fp4(wh, 1.0f, 1);
            unsigned wl = __builtin_amdgcn_cvt_scalef32_pk_fp4_f32(0u, (x0 - d01.x) * 4.0f, (x1 - d01.y) * 4.0f, 1.0f, 0); wl = __builtin_amdgcn_cvt_scalef32_pk_fp4_f32(wl, (x2 - d23.x) * 4.0f, (x3 - d23.y) * 4.0f, 1.0f, 1);
            *(unsigned short*)(dst8 + (c0 >> 1)) = (unsigned short)wh; *(unsigned short*)(dst8 + 512 + (c0 >> 1)) = (unsigned short)wl; }
    }
}

__device__ __forceinline__ int f2sort(float f) { const int b = __float_as_int(f); return b ^ ((b >> 31) & 0x7fffffff); }
__device__ __forceinline__ float sort2f(int k) { return __int_as_float(k ^ ((k >> 31) & 0x7fffffff)); }
__device__ __forceinline__ void route_group(const Params& p, LAS float* sbuf, const int tg, const int h, const int lane) {
    const int r16 = lane & 15, q = lane >> 4;
    const bf16* QP = (const bf16*)(p.ws + WS_QP);
    const bf16* SK = (const bf16*)(p.ws + WS_SUBK16);
    int* ridx = (int*)(p.ws + WS_RIDX); float* rgate = (float*)(p.ws + WS_RGATE);
    {
        const int tok = tg * 64 + lane;
        int l1[16], l2[16];
#pragma unroll
        for (int c = 0; c < 2; ++c) {
            int lst[16];
#pragma unroll
            for (int k = 0; k < 16; ++k) lst[k] = (int)0x80000000;
#pragma unroll 1
            for (int kh = 0; kh < 2; ++kh) {
                u32x4 Aq[4][2];
#pragma unroll
                for (int mt = 0; mt < 4; ++mt)
#pragma unroll
                for (int ks_ = 0; ks_ < 2; ++ks_) Aq[mt][ks_] = *(const u32x4*)(QP + (size_t)(tg * 64 + 16 * mt + r16) * 1024 + h * 128 + c * 64 + 32 * ks_ + 8 * q);
                u32x4 Bk[4][2];
#pragma unroll
                for (int nt = 0; nt < 4; ++nt)
#pragma unroll
                    for (int ks_ = 0; ks_ < 2; ++ks_) Bk[nt][ks_] = *(const u32x4*)(SK + ((size_t)((h * 2 + c) * 128 + kh * 64 + 16 * nt + r16)) * 64 + 32 * ks_ + 8 * q);
#pragma unroll
                for (int mt = 0; mt < 4; ++mt)
#pragma unroll
                    for (int nt = 0; nt < 4; ++nt) { f32x4 acc = (f32x4){0.f, 0.f, 0.f, 0.f};
                        acc = __builtin_amdgcn_mfma_f32_16x16x32_bf16(__builtin_bit_cast(bf16x8, Aq[mt][0]), __builtin_bit_cast(bf16x8, Bk[nt][0]), acc, 0, 0, 0);
                        acc = __builtin_amdgcn_mfma_f32_16x16x32_bf16(__builtin_bit_cast(bf16x8, Aq[mt][1]), __builtin_bit_cast(bf16x8, Bk[nt][1]), acc, 0, 0, 0);
#pragma unroll
                        for (int r = 0; r < 4; ++r) sbuf[(16 * mt + 4 * q + r) * 68 + 16 * nt + r16] = acc[r]; }
                asm volatile("s_waitcnt lgkmcnt(0)" ::: "memory");
#pragma unroll 4
                for (int n4 = 0; n4 < 16; ++n4) { const f32x4 s4 = *(const LAS f32x4*)(sbuf + lane * 68 + 4 * n4);
#pragma unroll
                    for (int j = 0; j < 4; ++j) { const int n = kh * 64 + 4 * n4 + j; int key = (f2sort(s4[j]) & ~127) | (127 - n);
#pragma unroll
                        for (int k = 0; k < 16; ++k) { const int mx = max(lst[k], key); key = min(lst[k], key); lst[k] = mx; } } }
                asm volatile("s_waitcnt lgkmcnt(0)" ::: "memory");
            }
#pragma unroll
            for (int k = 0; k < 16; ++k) { if (c == 0) l1[k] = lst[k]; else l2[k] = lst[k]; }
        }
        float cs[16]; int cp[16];
        { const float v0 = sort2f(l1[0] & ~127); const int p0 = (127 - (l1[0] & 127)) << 7;
#pragma unroll
          for (int k = 0; k < 16; ++k) { cs[k] = v0 + sort2f(l2[k] & ~127); cp[k] = p0 | (127 - (l2[k] & 127)); } }
#pragma unroll
        for (int a = 1; a < 16; ++a)
#pragma unroll
            for (int bq = 0; bq < 16; ++bq) if ((a + 1) * (bq + 1) <= 16) {
                float v = sort2f(l1[a] & ~127) + sort2f(l2[bq] & ~127);
                int pay = ((127 - (l1[a] & 127)) << 7) | (127 - (l2[bq] & 127));
#pragma unroll
                for (int k = 0; k < 16; ++k) { const bool gt = v > cs[k]; const float tv = gt ? cs[k] : v; const int tp = gt ? cp[k] : pay; cs[k] = gt ? v : cs[k]; cp[k] = gt ? pay : cp[k]; v = tv; pay = tp; }
            }
        float e[16], sum = 0.f;
#pragma unroll
        for (int k = 0; k < 16; ++k) { e[k] = __expf(cs[k] - cs[0]); sum += e[k]; }
        const float rinv = 1.0f / sum;
        int tokw = tok; asm volatile("" : "+v"(tokw));
        const size_t ro = ((size_t)tokw * 8 + h) * 16;
#pragma unroll
        for (int k4 = 0; k4 < 4; ++k4) { *(int4*)(ridx + ro + 4 * k4) = make_int4(cp[4 * k4], cp[4 * k4 + 1], cp[4 * k4 + 2], cp[4 * k4 + 3]);
            *(f32x4*)(rgate + ro + 4 * k4) = (f32x4){e[4 * k4] * rinv, e[4 * k4 + 1] * rinv, e[4 * k4 + 2] * rinv, e[4 * k4 + 3] * rinv}; }
    }
}

__device__ __forceinline__ float gelu_tanh(float x) { const float z = 0.7978845608028654f * (x + 0.044715f * x * x * x); const float t = 1.0f - 2.0f * __builtin_amdgcn_rcpf(__expf(2.0f * z) + 1.0f); return 0.5f * x * (1.0f + t); }
__device__ __forceinline__ void unpack8(const u32x4 v, float (&o)[8]) { o[0] = bf_lo(v.x); o[1] = bf_hi(v.x); o[2] = bf_lo(v.y); o[3] = bf_hi(v.y); o[4] = bf_lo(v.z); o[5] = bf_hi(v.z); o[6] = bf_lo(v.w); o[7] = bf_hi(v.w); }
__device__ __forceinline__ void unpack_fp4x16(unsigned w0, unsigned w1, float (&o)[16]) {
    f32x2 t;
    t = __builtin_amdgcn_cvt_scalef32_pk_f32_fp4(w0, 1.0f, 0); o[0] = t.x; o[1] = t.y;   t = __builtin_amdgcn_cvt_scalef32_pk_f32_fp4(w0, 1.0f, 1); o[2] = t.x; o[3] = t.y;
    t = __builtin_amdgcn_cvt_scalef32_pk_f32_fp4(w0, 1.0f, 2); o[4] = t.x; o[5] = t.y;   t = __builtin_amdgcn_cvt_scalef32_pk_f32_fp4(w0, 1.0f, 3); o[6] = t.x; o[7] = t.y;
    t = __builtin_amdgcn_cvt_scalef32_pk_f32_fp4(w1, 1.0f, 0); o[8] = t.x; o[9] = t.y;   t = __builtin_amdgcn_cvt_scalef32_pk_f32_fp4(w1, 1.0f, 1); o[10] = t.x; o[11] = t.y;
    t = __builtin_amdgcn_cvt_scalef32_pk_f32_fp4(w1, 1.0f, 2); o[12] = t.x; o[13] = t.y; t = __builtin_amdgcn_cvt_scalef32_pk_f32_fp4(w1, 1.0f, 3); o[14] = t.x; o[15] = t.y;
}
__device__ __forceinline__ void unpack_fp4x16_v2(unsigned w0, unsigned w1, f32x2 (&o)[8]) {
    o[0] = __builtin_amdgcn_cvt_scalef32_pk_f32_fp4(w0, 1.0f, 0); o[1] = __builtin_amdgcn_cvt_scalef32_pk_f32_fp4(w0, 1.0f, 1);
    o[2] = __builtin_amdgcn_cvt_scalef32_pk_f32_fp4(w0, 1.0f, 2); o[3] = __builtin_amdgcn_cvt_scalef32_pk_f32_fp4(w0, 1.0f, 3);
    o[4] = __builtin_amdgcn_cvt_scalef32_pk_f32_fp4(w1, 1.0f, 0); o[5] = __builtin_amdgcn_cvt_scalef32_pk_f32_fp4(w1, 1.0f, 1);
    o[6] = __builtin_amdgcn_cvt_scalef32_pk_f32_fp4(w1, 1.0f, 2); o[7] = __builtin_amdgcn_cvt_scalef32_pk_f32_fp4(w1, 1.0f, 3);
}
template <int CTRL, int BANK> __device__ __forceinline__ float dpp_f(float oldv, float src) { return __int_as_float(__builtin_amdgcn_update_dpp(__float_as_int(oldv), __float_as_int(src), CTRL, 0xF, BANK, false)); }
__device__ __forceinline__ float reduce8(const float (&d)[8], int lane) {
    const bool b0 = lane & 1, b1 = lane & 2, b2 = lane & 4;
    float r[4];
#pragma unroll
    for (int m = 0; m < 4; ++m) { const float keep = b0 ? d[2 * m + 1] : d[2 * m], send = b0 ? d[2 * m] : d[2 * m + 1]; r[m] = keep + dpp_f<0xB1, 0xF>(0.f, send); }
    float s2[2];
#pragma unroll
    for (int m = 0; m < 2; ++m) { const float keep = b1 ? r[2 * m + 1] : r[2 * m], send = b1 ? r[2 * m] : r[2 * m + 1]; s2[m] = keep + dpp_f<0x4E, 0xF>(0.f, send); }
    const float keep = b2 ? s2[1] : s2[0], send = b2 ? s2[0] : s2[1];
    float t = dpp_f<0x104, 0x5>(0.f, send);
    t = dpp_f<0x114, 0xA>(t, send);
    float u = keep + t;
    u += dpp_f<0x128, 0xF>(0.f, u);
    u += __shfl_xor(u, 16);
    u += __shfl_xor(u, 32);
    return u;
}
typedef int v8i_t __attribute__((ext_vector_type(8)));
#ifndef USE_NT
#define USE_NT 0
#endif
#if USE_NT & 1
#define NT_LOAD(p_) __builtin_nontemporal_load(p_)
#else
#define NT_LOAD(p_) (*(p_))
#endif
#if USE_NT & 2
#define NT_STORE(v_, p_) __builtin_nontemporal_store(v_, p_)
#else
#define NT_STORE(v_, p_) (*(p_) = (v_))
#endif
#ifndef PROBE_CVT
#define PROBE_CVT 0
#endif
#if PROBE_CVT == 1
#define PROBE_CVT_EXTRA(a_, b_) do { f32x2 d0_, d1_, d2_, d3_; asm volatile("v_cvt_scalef32_pk_f32_fp4 %0, %4, 1.0\n\tv_cvt_scalef32_pk_f32_fp4 %1, %4, 1.0 op_sel:[1,0,0]\n\tv_cvt_scalef32_pk_f32_fp4 %2, %5, 1.0\n\tv_cvt_scalef32_pk_f32_fp4 %3, %5, 1.0 op_sel:[1,0,0]\n\t" \
        "v_cvt_scalef32_pk_f32_fp4 %0, %4, 1.0 op_sel:[0,1,0]\n\tv_cvt_scalef32_pk_f32_fp4 %1, %4, 1.0 op_sel:[1,1,0]\n\tv_cvt_scalef32_pk_f32_fp4 %2, %5, 1.0 op_sel:[0,1,0]\n\tv_cvt_scalef32_pk_f32_fp4 %3, %5, 1.0 op_sel:[1,1,0]" : "=&v"(d0_), "=&v"(d1_), "=&v"(d2_), "=&v"(d3_) : "v"(a_), "v"(b_)); } while (0)
#elif PROBE_CVT == 2
#define PROBE_CVT_EXTRA(a_, b_) do { f32x2 d0_, d1_, d2_, d3_; asm volatile("v_pk_mul_f32 %0, %4, %4\n\tv_pk_mul_f32 %1, %4, %4\n\tv_pk_mul_f32 %2, %4, %4\n\tv_pk_mul_f32 %3, %4, %4\n\t" \
        "v_pk_mul_f32 %0, %4, %4\n\tv_pk_mul_f32 %1, %4, %4\n\tv_pk_mul_f32 %2, %4, %4\n\tv_pk_mul_f32 %3, %4, %4" : "=&v"(d0_), "=&v"(d1_), "=&v"(d2_), "=&v"(d3_) : "v"(acc_)); } while (0)
#else
#define PROBE_CVT_EXTRA(a_, b_) do { } while (0)
#endif
#define EXP_LOADU(ua, idv_, gb_) do { int r16o_ = r16; asm volatile("" : "+v"(r16o_)); const int eid_ = __shfl((idv_), (gb_) + r16o_); const unsigned char* ur_ = PU + (size_t)eid_ * 512 + 16 * q; \
        _Pragma("unroll") for (int ks_ = 0; ks_ < 8; ++ks_) ua[ks_] = *(const u32x4*)(ur_ + 64 * ks_); } while (0)
#define EXP_LOADV(vv, idv_, gb_) do { _Pragma("unroll") for (int j = 0; j < 16; ++j) { const int e_ = __builtin_amdgcn_readlane((idv_), (gb_) + j); vv[j] = *(const u32x2*)(PVt + (size_t)e_ * 512 + 8 * lane); } } while (0)
#define EXP_COMPUTE(ua, vv, gv_, gb_, idn_, gbn_) do { f32x4 acc_ = (f32x4){0.f, 0.f, 0.f, 0.f}, accl_ = (f32x4){0.f, 0.f, 0.f, 0.f}; \
        _Pragma("unroll") for (int ks_ = 0; ks_ < 8; ++ks_) { const v8i_t a8 = {(int)ua[ks_].x, (int)ua[ks_].y, (int)ua[ks_].z, (int)ua[ks_].w, 0, 0, 0, 0}; \
            const u32x4 bh_ = *(const LAS u32x4*)(xs8 + 64 * ks_ + 16 * q), bl_ = *(const LAS u32x4*)(xs8 + 512 + 64 * ks_ + 16 * q); \
            const v8i_t b8h = {(int)bh_.x, (int)bh_.y, (int)bh_.z, (int)bh_.w, 0, 0, 0, 0}, b8l = {(int)bl_.x, (int)bl_.y, (int)bl_.z, (int)bl_.w, 0, 0, 0, 0}; \
            acc_ = __builtin_amdgcn_mfma_scale_f32_16x16x128_f8f6f4(a8, b8h, acc_, 4, 4, 0, 0, 0, 0); accl_ = __builtin_amdgcn_mfma_scale_f32_16x16x128_f8f6f4(a8, b8l, accl_, 4, 4, 0, 0, 0, 0); } \
        acc_ = acc_ + accl_ * 0.25f; \
        asm volatile("" ::: "memory"); \
        EXP_LOADU(ua, idn_, gbn_);            \
        float av_[4]; \
        int q4o_ = 4 * q; asm volatile("" : "+v"(q4o_)); \
        _Pragma("unroll") for (int r = 0; r < 4; ++r) av_[r] = gelu_tanh(acc_[r] * (1.0f / 84.0f)) * __shfl((gv_), (gb_) + q4o_ + r) * 0.2f; \
        _Pragma("unroll") for (int j = 0; j < 16; ++j) { const float a = rdlane(av_[j & 3], 16 * (j >> 2)); float t[16]; \
            unsigned w0_ = vv[j].x, w1_ = vv[j].y; asm volatile("" : "+v"(w0_), "+v"(w1_));        \
            PROBE_CVT_EXTRA(w0_, w1_); unpack_fp4x16(w0_, w1_, t);                                                            \
            _Pragma("unroll") for (int k = 0; k < 16; ++k) out[k] += a * t[k]; \
            asm volatile("" :: "v"(out[0]), "v"(out[1]), "v"(out[2]), "v"(out[3]), "v"(out[4]), "v"(out[5]), "v"(out[6]), "v"(out[7]), "v"(out[8]), "v"(out[9]), "v"(out[10]), "v"(out[11]), "v"(out[12]), "v"(out[13]), "v"(out[14]), "v"(out[15]) : "memory"); \
            { const int e_ = __builtin_amdgcn_readlane((idn_), (gbn_) + j); vv[j] = *(const u32x2*)(PVt + (size_t)e_ * 512 + 8 * lane); } } } while (0)
__device__ __forceinline__ int claim_token(LAS int* qc, const int lane) {
    int t = 0;
    if (lane == 0) t = __hip_atomic_fetch_add(qc, 1, __ATOMIC_RELAXED, __HIP_MEMORY_SCOPE_WORKGROUP);
    return __builtin_amdgcn_readfirstlane(t);
}
__device__ __forceinline__ void experts_tokens(const Params& p, LAS unsigned char* xs8, LAS const float* g2fn, const int lane_in, const int tok_base, LAS int* qc) {
    int lane = lane_in;
    const int r16 = lane_in & 15, q = lane_in >> 4;
    const unsigned char* X8 = p.ws + WS_X8; const unsigned char* PU = p.ws + WS_PU; const unsigned char* PVt = p.ws + WS_PV;
    const int* ridx = (const int*)(p.ws + WS_RIDX); const float* rgate = (const float*)(p.ws + WS_RGATE);
    const int c0_ = claim_token(qc, lane_in);
    if (c0_ >= 64) return;
    const int gw = tok_base + c0_;
    int idn0 = ridx[(size_t)gw * 128 + lane], idn1 = ridx[(size_t)gw * 128 + 64 + lane];
    float gn0 = rgate[(size_t)gw * 128 + lane], gn1 = rgate[(size_t)gw * 128 + 64 + lane];
    u32x4 xrow = *(const u32x4*)(X8 + (size_t)gw * 1024 + 16 * lane);
    u32x4 ua[8]; u32x2 vv[16];
    EXP_LOADU(ua, idn0, 0); asm volatile("" ::: "memory"); EXP_LOADV(vv, idn0, 0);
    for (int tok = gw;;) {
        asm volatile("" : "+v"(lane));
        const int id0 = idn0, id1 = idn1; const float g0 = gn0, g1 = gn1;
        int tokn = tok; bool more = false;
        { int lo16 = 16 * lane; asm volatile("" : "+v"(lo16)); *(LAS u32x4*)(xs8 + lo16) = xrow; }
        asm volatile("s_waitcnt lgkmcnt(0)" ::: "memory");
        float out[16];
#pragma unroll
        for (int k = 0; k < 16; ++k) out[k] = 0.f;
#pragma unroll 1
        for (int g = 0; g < 7; ++g) {
            const int gn = g + 1;
            if (g == 5) { const int c_ = claim_token(qc, lane); more = c_ < 64; tokn = more ? tok_base + c_ : tok;
                idn0 = ridx[(size_t)tokn * 128 + lane]; idn1 = ridx[(size_t)tokn * 128 + 64 + lane]; gn0 = rgate[(size_t)tokn * 128 + lane]; gn1 = rgate[(size_t)tokn * 128 + 64 + lane];
                xrow = *(const u32x4*)(X8 + (size_t)tokn * 1024 + 16 * lane); }
            const int idvn = gn < 4 ? id0 : id1;
            const float gv = g < 4 ? g0 : g1;
            EXP_COMPUTE(ua, vv, gv, 16 * (g & 3), idvn, 16 * (gn & 3));
            __builtin_amdgcn_sched_barrier(0);
        }
        int l16 = 16 * lane; asm volatile("" : "+v"(l16));
        float* xr = p.out + (size_t)tok * 1024 + l16;
        EXP_COMPUTE(ua, vv, g1, 48, idn0, 0);
        __builtin_amdgcn_sched_barrier(0);
        f32x4 xv[4];
#pragma unroll
        for (int k4 = 0; k4 < 4; ++k4) xv[k4] = NT_LOAD((const f32x4*)(xr + 4 * k4));
        float xn[16]; float ss = 0.f;
#pragma unroll
        for (int k4 = 0; k4 < 4; ++k4) { const f32x4 gg = *(LAS const f32x4*)(g2fn + l16 + 4 * k4);
#pragma unroll
            for (int j = 0; j < 4; ++j) { const float v = xv[k4][j] + gg[j] * out[4 * k4 + j]; xn[4 * k4 + j] = v; ss += v * v; } }
        ss = wave_sum_dpp(ss);
        const float rs = 1.0f / sqrtf(ss * (1.0f / 1024.0f) + EPSF);
#pragma unroll
        for (int k4 = 0; k4 < 4; ++k4) { const f32x4 nn = *(LAS const f32x4*)(g2fn + 1024 + l16 + 4 * k4);
            f32x4 o;
#pragma unroll
            for (int j = 0; j < 4; ++j) o[j] = xn[4 * k4 + j] * rs * nn[j];
            NT_STORE(o, (f32x4*)(xr + 4 * k4)); }
        if (!more) break;
        tok = tokn;
    }
}
#undef EXP_LOADU
#undef EXP_LOADV
#undef EXP_COMPUTE
#ifndef NEW_
#define NEW_ 6
#endif
__device__ __forceinline__ void route_experts_groups(const int wv, const Params& p, unsigned char* smem, const int g_first, const int g_count) {
    const int wave = wv;
    LAS unsigned char* xs8 = (LAS unsigned char*)smem + wave * 1024;
    LAS float* sbuf = (LAS float*)((LAS unsigned char*)smem + 8192 + wave * 17408);
    LAS int* qctr = (LAS int*)((LAS unsigned char*)smem + 8192 + 8 * 17408);
    LAS float* g2fn = (LAS float*)((LAS unsigned char*)smem + 8192 + 8 * 17408 + 256);
    { const int t_ = opaque_tid(wv); const float* mod = (const float*)(p.ws + WS_MOD);
      *(LAS f32x4*)(g2fn + 4 * t_) = t_ < 256 ? *(const f32x4*)(mod + ((g_first * 64) >> 13) * 6144 + 5120 + 4 * t_) : *(const f32x4*)(p.in[I_FNORM] + 4 * (t_ - 256)); }
    const int ngr = g_first + g_count;
    int g = g_first;
    if (g < ngr) route_group(p, sbuf, g, wave, opaque_tid(wv) & 63);
    if (opaque_tid(wv) == 0) { qctr[0] = 0; qctr[1] = 0; }
    asm volatile("s_waitcnt vmcnt(0) lgkmcnt(0)" ::: "memory"); __syncthreads();
#pragma unroll 1
    for (; g < ngr; ++g) {
        const int gn = g + 1;
        const int lane = opaque_tid(wv) & 63;
        const unsigned long long tp0_ = (PROBE_SEC == 27 || PROBE_SEC == 28) ? __builtin_amdgcn_s_memrealtime() : 0ull;
        if (wave >= NEW_ && gn < ngr) {
#pragma unroll 1
            for (int h = wave - NEW_; h < 8; h += 8 - NEW_) route_group(p, sbuf, gn, h, opaque_tid(wv) & 63); }
        experts_tokens(p, xs8, g2fn, opaque_tid(wv) & 63, g * 64, qctr + (g & 1));
        if (opaque_tid(wv) == 0) qctr[(g + 1) & 1] = 0;
        if ((PROBE_SEC == 27 && wave == 0 && lane == 0) || (PROBE_SEC == 28 && wave == NEW_ && lane == 0)) atomicAdd((unsigned long long*)(p.ws + WS_BAR) + blockIdx.x, __builtin_amdgcn_s_memrealtime() - tp0_);
        asm volatile("s_waitcnt vmcnt(0) lgkmcnt(0)" ::: "memory"); __syncthreads();
    }
}

__device__ __forceinline__ void ph2_inproj(const int wv, const Params& p, unsigned char* smem) {
    unsigned char* ws = p.ws;
    PG8_LAS unsigned char* lds = (PG8_LAS unsigned char*)smem;
    { pg8::Gemm g{(const pg8::bf16_t*)(ws + WS_A), (const pg8::bf16_t*)(ws + WS_WINT), NTOK, PROJW, DM};
      pg8::StaticOrder S; S.init(NTOK, PROJW, gridDim.x, blockIdx.x);
      static_assert(WS_G == WS_V + (size_t)NTOK * 1024 * 2, "V and G must be contiguous");
      EpiInProj E{(bf16*)(ws + WS_ZT), (bf16*)(ws + WS_QK), (bf16*)(ws + WS_V), (bf16*)p.out, (const float2*)(ws + WS_ROT)};
      pg8::gemm_phase<EpiInProj, pg8::StaticOrder, false>(lds, g, S, E, PG8_PROBE_PTR, wv); }
    { pg8::Gemm g{(const pg8::bf16_t*)(ws + WS_HCTX), (const pg8::bf16_t*)(ws + WS_WINT) + (size_t)3584 * 1024, NCTX, 1536, DM};
      pg8::StaticOrder S; S.init(NCTX, 1536, gridDim.x, blockIdx.x);
      EpiCtx E{(bf16*)(ws + WS_CK), (bf16*)(ws + WS_CV)};
      pg8::gemm_phase<EpiCtx, pg8::StaticOrder, false>(lds, g, S, E, PG8_PROBE_PTR, wv); }
}
struct PanelOrder {
    int pm, nN;
    __device__ __forceinline__ bool next(int i, pg8::Unit& u) const { if (i >= nN) return false; u.pm = pm; u.pn = i; return true; }
    __device__ __forceinline__ void a_ready(const pg8::Unit&) const {}
    __device__ __forceinline__ void done(const pg8::Unit&) const {}
};
#define BLOCK_SEAM() do { asm volatile("s_waitcnt vmcnt(0)" ::: "memory"); __syncthreads(); } while (0)
__device__ __forceinline__ void ph_tail(const int wv, const Params& p, unsigned char* smem) {
    unsigned char* ws = p.ws;
    PG8_LAS unsigned char* lds = (PG8_LAS unsigned char*)smem;
    { const int pm = blockIdx.x;
        SEC_BEGIN(21);
        readout_items(wv, p, pm * 1024, pm * 1024 + 1024, wv, 8);
        BLOCK_SEAM();
        SEC_END(21, ws); SEC_BEGIN(22);
        { pg8::Gemm g{(const pg8::bf16_t*)(ws + WS_YH), (const pg8::bf16_t*)(ws + WS_WHYT), NTOK, DM, DM};
          PanelOrder S{pm, 4};
          EpiMerge<0> E{(bf16*)(ws + WS_M), (const bf16*)p.out};
          pg8::gemm_phase<EpiMerge<0>, PanelOrder, false>(lds, g, S, E, PG8_PROBE_PTR, wv); }
        SEC_END(22, ws); SEC_BEGIN(23);
        { pg8::Gemm g{(const pg8::bf16_t*)(ws + WS_OF), (const pg8::bf16_t*)(ws + WS_WRETT), NTOK, DM, DM};
          PanelOrder S{pm, 4};
          EpiMerge<1> E{(bf16*)(ws + WS_M), (const bf16*)p.out + 262144};
          pg8::gemm_phase<EpiMerge<1>, PanelOrder, false>(lds, g, S, E, PG8_PROBE_PTR, wv); }
        BLOCK_SEAM();
        SEC_END(23, ws); SEC_BEGIN(24);
        { pg8::Gemm g{(const pg8::bf16_t*)(ws + WS_M), (const pg8::bf16_t*)(ws + WS_WOT), NTOK, DM, DM};
          PanelOrder S{pm, 4};
          EpiResid E{p.in[I_X], p.out, (const float*)(ws + WS_MOD)};
          pg8::gemm_phase<EpiResid, PanelOrder, false>(lds, g, S, E, PG8_PROBE_PTR, wv); }
        BLOCK_SEAM();
        SEC_END(24, ws); SEC_BEGIN(25);
        rows2_range(wv, p, pm * 256, pm * 256 + 256);
        BLOCK_SEAM();
        SEC_END(25, ws); SEC_BEGIN(26);
        { pg8::Gemm g{(const pg8::bf16_t*)(ws + WS_H2), (const pg8::bf16_t*)(ws + WS_WQT), NTOK, DM, DM};
          PanelOrder S{pm, 4};
          pg8::EpiBf16<0> E{(pg8::bf16_t*)(ws + WS_QP), DM, nullptr, 0, 0};
          pg8::gemm_phase<pg8::EpiBf16<0>, PanelOrder, false>(lds, g, S, E, PG8_PROBE_PTR, wv); }
        BLOCK_SEAM();
        SEC_END(26, ws); SEC_BEGIN(29);
        route_experts_groups(wv, p, smem, pm * 4, 4);
        BLOCK_SEAM();
        SEC_END(29, ws);
    }
}

#define XB_TMO      128
#define XB_XCNT(j)  (256  + 64 * (j))
#define XB_XSUB(j)  (1280 + 64 * (j))
#define XB_XGEN(j)  (2304 + 64 * (j))
#define XB_TOP      3328
#define XB_TOPGEN   3392
#define XCD_BAR_WORDS 3456
#define XB_SPIN_CAP (1u << 22)
__device__ __forceinline__ unsigned xb_ld(unsigned* p)              { return __hip_atomic_load(p, __ATOMIC_RELAXED, __HIP_MEMORY_SCOPE_AGENT); }
__device__ __forceinline__ unsigned xb_add(unsigned* p, unsigned v) { return __hip_atomic_fetch_add(p, v, __ATOMIC_RELAXED, __HIP_MEMORY_SCOPE_AGENT); }
__device__ __forceinline__ unsigned xb_xcc_id() { return (unsigned)__builtin_amdgcn_s_getreg((3 << 11) | 20) & 0xFu; }
#define XB_SPIN(cond, bar) do { unsigned _sp = 0; while (cond) { __builtin_amdgcn_s_sleep(1); \
    if ((++_sp & 255u) == 0u) { if (xb_ld(&(bar)[XB_TMO])) break; if (_sp > XB_SPIN_CAP) { atomicAdd(&(bar)[XB_TMO], 1u); break; } } } } while (0)
struct XcdBarrier { unsigned* bar; unsigned x; unsigned nloc, nx; };
__device__ __forceinline__ void xcd_barrier_post(XcdBarrier& b, unsigned* bar) {
    b.bar = bar; b.x = xb_xcc_id(); b.nloc = 0u; b.nx = 0u;
    if (threadIdx.x == 0) (void)xb_add(&bar[XB_XCNT(b.x)], 1u);
}
__device__ __forceinline__ void xcd_barrier_complete(unsigned* bar, unsigned x, unsigned& nloc, unsigned& nx) {
    const unsigned G = gridDim.x * gridDim.y * gridDim.z;
    unsigned sum, cnt, mine, sp = 0u;
    for (;;) {
        sum = 0u; cnt = 0u; mine = 0u;
#pragma unroll
        for (unsigned j = 0; j < 16; ++j) { const unsigned c = xb_ld(&bar[XB_XCNT(j)]); sum += c; cnt += (c > 0u) ? 1u : 0u; mine = (j == x) ? c : mine; }
        if (sum == G) break;
        __builtin_amdgcn_s_sleep(1);
        if ((++sp & 255u) == 0u) { if (xb_ld(&bar[XB_TMO])) break; if (sp > XB_SPIN_CAP) { atomicAdd(&bar[XB_TMO], 1u); break; } }
    }
    nloc = mine > 0u ? mine : 1u; nx = cnt > 0u ? cnt : 1u;
}
__device__ __forceinline__ void xcd_barrier(XcdBarrier& b) {
    asm volatile("s_waitcnt vmcnt(0)" ::: "memory");
    __syncthreads();
    if (threadIdx.x == 0) {
        unsigned* bar = b.bar;
        __builtin_amdgcn_s_waitcnt(0);
        if (b.nloc == 0u) xcd_barrier_complete(bar, b.x, b.nloc, b.nx);
        const unsigned nloc = b.nloc, nx = b.nx;
        const unsigned old = xb_add(&bar[XB_XSUB(b.x)], 1u);
        const unsigned gen = old / nloc;
        if (old + 1u == (gen + 1u) * nloc) {
            __builtin_amdgcn_fence(__ATOMIC_RELEASE, "agent");
            asm volatile("s_waitcnt vmcnt(0)" ::: "memory");
            const unsigned og = xb_add(&bar[XB_TOP], 1u);
            const unsigned tg = og / nx;
            if (og + 1u == (tg + 1u) * nx) xb_add(&bar[XB_TOPGEN], 1u);
            else XB_SPIN(xb_ld(&bar[XB_TOPGEN]) == tg, bar);
            __builtin_amdgcn_fence(__ATOMIC_ACQUIRE, "agent");
            xb_add(&bar[XB_XGEN(b.x)], 1u);
            asm volatile("s_waitcnt vmcnt(0)" ::: "memory");
        } else {
            XB_SPIN(xb_ld(&bar[XB_XGEN(b.x)]) == gen, bar);
            __builtin_amdgcn_fence(__ATOMIC_ACQUIRE, "agent");
            asm volatile("s_waitcnt vmcnt(0)" ::: "memory");
        }
    }
    __syncthreads();
}

#ifndef ONE_LAUNCH
#define ONE_LAUNCH 1
#endif
template <int PH> __device__ __forceinline__ void run_phase(const int wv, const Params& p, unsigned char* smem) {
    if (PH == 0) ph0_prologue(wv, p, smem);
    if (PH == 1) ph1_rows_and_taps(wv, p, smem);
    if (PH == 2) ph2_inproj(wv, p, smem);
    if (PH == 3) { ph3a_filter_spectrum(wv, p, smem); BLOCK_SEAM(); ph3b_hyena_fftconv(wv, p, smem); }
    if (PH == 4) { ph4_retention(wv, p, smem); { SEC_BEGIN(7); ph4_transpose_yh(wv, p, smem); SEC_END(7, p.ws); } convert_expert_tables(wv, p); }
    if (PH == 11) ph_tail(wv, p, smem);
}
#if ONE_LAUNCH
#ifndef PROBE_PH
#define PROBE_PH (-1)
#endif
#ifndef PROBE_SYNC
#define PROBE_SYNC 0
#endif
#ifndef USE_XCD_BARRIER
#define USE_XCD_BARRIER 0
#endif
#ifndef PROBE_CLK
#define PROBE_CLK 0
#endif
#define RUN_PHASE(PH) do { const unsigned long long t0_ = (PROBE_PH == (PH)) ? (PROBE_CLK ? (unsigned long long)__builtin_readcyclecounter() / 21ull : __builtin_amdgcn_s_memrealtime()) : 0ull; run_phase<PH>(wv, p, smem); if (!USE_XCD_BARRIER || (PH) == 0) grid.sync(); else xcd_barrier(xb); \
        if (PROBE_PH == (PH)) { const unsigned long long t1c_ = PROBE_CLK ? (unsigned long long)__builtin_readcyclecounter() / 21ull : 0ull; const unsigned long long t1_ = __builtin_amdgcn_s_memrealtime(); const unsigned long long dt_ = 3ull * ((PROBE_CLK ? t1c_ : t1_) - t0_); \
            while (__builtin_amdgcn_s_memrealtime() - t1_ < dt_) __builtin_amdgcn_s_sleep(64); } } while (0)
__global__ void __launch_bounds__(NTHR, 2) fwd_megakernel(Params p) {
    extern __shared__ __attribute__((aligned(16))) unsigned char smem[];
    cg::grid_group grid = cg::this_grid();
    const int wv = __builtin_amdgcn_readfirstlane(threadIdx.x >> 6);
    XcdBarrier xb; if (USE_XCD_BARRIER) xcd_barrier_post(xb, (unsigned*)(p.ws + WS_BAR));
    RUN_PHASE(0); RUN_PHASE(1); RUN_PHASE(2); RUN_PHASE(3); RUN_PHASE(4);
#if PROBE_SYNC
    for (int i_ = 0; i_ < 16; ++i_) grid.sync();
#endif
#if PROBE_SEC >= 0
    run_phase<11>(wv, p, smem);
    { __syncthreads(); const unsigned long long acc_ = __hip_atomic_load((unsigned long long*)(p.ws + WS_BAR) + blockIdx.x, __ATOMIC_RELAXED, __HIP_MEMORY_SCOPE_AGENT);
      const unsigned long long t1_ = __builtin_amdgcn_s_memrealtime(); while (__builtin_amdgcn_s_memrealtime() - t1_ < 3ull * acc_) __builtin_amdgcn_s_sleep(64); }
#elif PROBE_PH == 11
    { const unsigned long long t0_ = __builtin_amdgcn_s_memrealtime(); run_phase<11>(wv, p, smem); const unsigned long long t1_ = __builtin_amdgcn_s_memrealtime(); const unsigned long long dt_ = 3ull * (t1_ - t0_);
      while (__builtin_amdgcn_s_memrealtime() - t1_ < dt_) __builtin_amdgcn_s_sleep(64); }
#else
    run_phase<11>(wv, p, smem);
#endif
}
#else
template <int PH> __global__ void __launch_bounds__(NTHR, 2) k_phase(Params p) {
    extern __shared__ __attribute__((aligned(16))) unsigned char smem[];
    const int wv = __builtin_amdgcn_readfirstlane(threadIdx.x >> 6);
    run_phase<PH>(wv, p, smem);
}
#endif

extern "C" void kernel_launch(void* const* d_in, const int* in_sizes, int n_in, void* d_out, int out_size, void* d_ws, size_t ws_size, hipStream_t stream) {
    static int grid = 0;
    if (grid == 0) {
        if (n_in != 31 || out_size != NTOK * DM || ws_size < WS_END) { fprintf(stderr, "kernel_launch: unexpected shapes (n_in %d out %d ws %zu)\n", n_in, out_size, ws_size); grid = -1; return; }
        int dev = 0, cus = 0;
        hipGetDevice(&dev); hipDeviceGetAttribute(&cus, hipDeviceAttributeMultiprocessorCount, dev);
#if ONE_LAUNCH
        int per_cu = 0;
        hipFuncSetAttribute((const void*)fwd_megakernel, hipFuncAttributeMaxDynamicSharedMemorySize, LDS_BYTES);
        hipOccupancyMaxActiveBlocksPerMultiprocessor(&per_cu, (const void*)fwd_megakernel, NTHR, LDS_BYTES);
        if (per_cu < 1) { fprintf(stderr, "kernel_launch: occupancy query says %d blocks/CU\n", per_cu); per_cu = 1; }
        if (cus != NTOK / 256) { fprintf(stderr, "kernel_launch: built for a %d-CU device (one 256-token panel per workgroup); this device reports %d CUs\n", NTOK / 256, cus); grid = -1; return; }
        grid = cus;
#else
#define SETATTR(PH) hipFuncSetAttribute((const void*)k_phase<PH>, hipFuncAttributeMaxDynamicSharedMemorySize, LDS_BYTES)
        SETATTR(0); SETATTR(1); SETATTR(2); SETATTR(3); SETATTR(4); SETATTR(5); SETATTR(6); SETATTR(7); SETATTR(8); SETATTR(9); SETATTR(10); SETATTR(11); SETATTR(12);
#undef SETATTR
        grid = cus;
#endif
        (void)hipGetLastError();
    }
    if (grid < 0) return;
    Params p{};
    for (int i = 0; i < 31; ++i) p.in[i] = (const float*)d_in[i];
    p.out = (float*)d_out; p.ws = (unsigned char*)d_ws;
#if ONE_LAUNCH
#if USE_XCD_BARRIER || PROBE_SEC >= 0
    (void)hipMemsetAsync((unsigned char*)d_ws + WS_BAR, 0, XCD_BAR_WORDS * 4, stream);
#endif
    void* args[] = {&p};
    hipError_t e = hipLaunchCooperativeKernel((const void*)fwd_megakernel, dim3(grid), dim3(NTHR), args, LDS_BYTES, stream);
    if (e != hipSuccess) fprintf(stderr, "cooperative launch failed: %s (grid %d)\n", hipGetErrorString(e), grid);
#else
#define LAUNCH(PH) hipLaunchKernelGGL(k_phase<PH>, dim3(grid), dim3(NTHR), LDS_BYTES, stream, p)
    LAUNCH(0); LAUNCH(1); LAUNCH(2); LAUNCH(3); LAUNCH(4); LAUNCH(5); LAUNCH(6); LAUNCH(7); LAUNCH(8); LAUNCH(9); LAUNCH(10); LAUNCH(11);
#undef LAUNCH
#endif
}
```

```cpp
#include <hip/hip_runtime.h>
#include <hip/hip_cooperative_groups.h>
#include <cstdio>
#include <cstdint>
#ifndef PROBE_SEC
#define PROBE_SEC (-1)
#endif
#if PROBE_SEC == 30 || PROBE_SEC == 31
#define PG8_EPI_T0 const unsigned long long _e0 = __builtin_amdgcn_s_memrealtime()
#define PG8_EPI_T1 do { if (PROBE_SEC == 31) asm volatile("s_waitcnt vmcnt(0)" ::: "memory"); const unsigned long long _e1 = __builtin_amdgcn_s_memrealtime(); if (tid == 0) atomicAdd(stamps + blockIdx.x, _e1 - _e0); } while (0)
#else
#define PG8_EPI_T0 do { } while (0)
#define PG8_EPI_T1 do { } while (0)
#endif
namespace pg8 {
#define PG8_LAS __attribute__((address_space(3)))
typedef unsigned short bf16_t;
typedef short bf16x8 __attribute__((ext_vector_type(8)));
typedef float f32x4 __attribute__((ext_vector_type(4)));
typedef unsigned u32x4 __attribute__((ext_vector_type(4)));
constexpr int BM = 256, BK = 64, HALF = 128, HTB = HALF * BK * 2  , STAGE_BYTES = 8 * HTB, NXCD = 8, WGM = 8;

__host__ __device__ __forceinline__ int lds_byte(int r, int c) { const int st = (r >> 4) * 2 + (c >> 5), rr = r & 15, cc = c & 31, ob = rr * 64 + cc * 2; return st * 1024 + (ob ^ (((ob >> 9) & 1) << 5)); }
__host__ __device__ __forceinline__ void stage_rc(int b, int& R, int& C) { const int st = b / 1024, sb = b % 1024, swz = sb ^ (((sb >> 9) & 1) << 5); R = (st >> 1) * 16 + swz / 64; C = (st & 1) * 32 + (swz % 64) / 2; }
__host__ __device__ __forceinline__ int perm32(int rho) { const int n = rho >> 4, i = rho & 15; return 8 * (i >> 2) + 4 * n + (i & 3); }

struct Unit { int pm, pn; };
struct Gemm { const bf16_t* A; const bf16_t* Bt; int M, N, K; };

struct StaticOrder {
    int nM, nN, nwg, G, c;
    __host__ __device__ void init(int M, int N, int G_, int c_) { nM = M / BM; nN = N / BM; nwg = nM * nN; G = G_; c = c_; }
    __host__ __device__ bool next(int i, Unit& u) const {
        const long L = (long)i * G + c; if (L >= nwg) return false;
        int wgid = (int)L; { const int q = nwg / NXCD, r = nwg % NXCD, xcd = wgid % NXCD, off = wgid / NXCD; wgid = (xcd < r ? xcd * (q + 1) : r * (q + 1) + (xcd - r) * q) + off; }
        const int nig = WGM * nN, gid = wgid / nig, fm = gid * WGM, gsz = (nM - fm) < WGM ? (nM - fm) : WGM;
        u.pm = fm + ((wgid % nig) % gsz); u.pn = (wgid % nig) / gsz; return true;
    }
    __device__ __forceinline__ void a_ready(const Unit&) const {}
    __device__ __forceinline__ void done(const Unit&) const {}
};
typedef __bf16 hw_bf16x2 __attribute__((ext_vector_type(2)));
typedef float hw_f32x2 __attribute__((ext_vector_type(2)));
__device__ __forceinline__ unsigned cvt_pk_bf16(float lo, float hi) { const hw_f32x2 v = {lo, hi}; return __builtin_bit_cast(unsigned, __builtin_convertvector(v, hw_bf16x2)); }
typedef float f32x2 __attribute__((ext_vector_type(2)));
__device__ __forceinline__ f32x2 gelu_pk(f32x2 v) {
    const f32x2 av = __builtin_elementwise_abs(v), d = av * 0.2316418882f + 1.0f;
    f32x2 t; t.x = __builtin_amdgcn_rcpf(d.x); t.y = __builtin_amdgcn_rcpf(d.y);
    f32x2 q = t * 0.5307027145f + (-0.7265760135f); q = q * t + 0.7107068705f; q = q * t + (-0.142248368f); q = q * t + 0.127414796f; q = q * t;
    const f32x2 s = (v * v) * (-0.72134752044f);
    f32x2 e; e.x = __builtin_amdgcn_exp2f(s.x); e.y = __builtin_amdgcn_exp2f(s.y);
    const f32x2 m = v * (q * e), r = v - m;
    f32x2 o; o.x = v.x < 0.f ? m.x : r.x; o.y = v.y < 0.f ? m.y : r.y; return o;
}

struct EpiF32 {
    static constexpr bool PERM = false, AFTER_DRAIN = false;
    float* C; int ldc; const float* bias;
    __device__ __forceinline__ void operator()(const f32x4 (&acc)[2][2][4][2], const Unit& u, int wr, int wc, int fr, int fq) const {
        const int row0 = u.pm * BM + wr * 64 + fr, col0 = u.pn * BM + wc * 32 + 4 * fq;
        f32x4 bv[2][2];
#pragma unroll
        for (int bj = 0; bj < 2; ++bj)
#pragma unroll
            for (int n = 0; n < 2; ++n) bv[bj][n] = bias ? *(const f32x4*)(bias + col0 + bj * HALF + n * 16) : (f32x4){0.f, 0.f, 0.f, 0.f};
#pragma unroll
        for (int ai = 0; ai < 2; ++ai)
#pragma unroll
            for (int m = 0; m < 4; ++m) { float* rowp = C + (size_t)(row0 + ai * HALF + m * 16) * ldc + col0;
#pragma unroll
                for (int bj = 0; bj < 2; ++bj)
#pragma unroll
                    for (int n = 0; n < 2; ++n) *(f32x4*)(rowp + bj * HALF + n * 16) = acc[ai][bj][m][n] + bv[bj][n]; }
    }
};
template <int ACT  > struct EpiBf16 {
    static constexpr bool PERM = true, AFTER_DRAIN = false;
    bf16_t* O; int ldc; const float* bias; int split_cols; size_t split_stride;
    __device__ __forceinline__ void operator()(const f32x4 (&acc)[2][2][4][2], const Unit& u, int wr, int wc, int fr, int fq) const {
        const int row0 = u.pm * BM + wr * 64 + fr; int colt = u.pn * BM; bf16_t* base = O;
        if (split_cols) { const int t = colt / split_cols; base += (size_t)t * split_stride; colt -= t * split_cols; }
        const int col0 = colt + wc * 32 + 8 * fq, bcol0 = u.pn * BM + wc * 32 + 8 * fq;
        f32x4 bv[2][2];
#pragma unroll
        for (int bj = 0; bj < 2; ++bj)
#pragma unroll
            for (int n = 0; n < 2; ++n) bv[bj][n] = bias ? *(const f32x4*)(bias + bcol0 + bj * HALF + 4 * n) : (f32x4){0.f, 0.f, 0.f, 0.f};
#pragma unroll
        for (int ai = 0; ai < 2; ++ai)
#pragma unroll
            for (int m = 0; m < 4; ++m) { bf16_t* rowp = base + (size_t)(row0 + ai * HALF + m * 16) * ldc + col0;
#pragma unroll
                for (int bj = 0; bj < 2; ++bj) { f32x4 v0 = acc[ai][bj][m][0] + bv[bj][0], v1 = acc[ai][bj][m][1] + bv[bj][1];
                    if (ACT == 1) { f32x2 a = gelu_pk((f32x2){v0[0], v0[1]}), b = gelu_pk((f32x2){v0[2], v0[3]}), c = gelu_pk((f32x2){v1[0], v1[1]}), d = gelu_pk((f32x2){v1[2], v1[3]});
                        v0 = (f32x4){a.x, a.y, b.x, b.y}; v1 = (f32x4){c.x, c.y, d.x, d.y}; }
                    if (ACT == 2) {
#pragma unroll
                        for (int j = 0; j < 4; ++j) { v0[j] = 0.5f * v0[j] * (1.0f + erff(v0[j] * 0.70710678f)); v1[j] = 0.5f * v1[j] * (1.0f + erff(v1[j] * 0.70710678f)); } }
                    u32x4 w; w.x = cvt_pk_bf16(v0[0], v0[1]); w.y = cvt_pk_bf16(v0[2], v0[3]); w.z = cvt_pk_bf16(v1[0], v1[1]); w.w = cvt_pk_bf16(v1[2], v1[3]);
                    *(u32x4*)(rowp + bj * HALF) = w; } }
    }
};
template <class Epi, class Sched, bool STAMP = false>
__device__ __forceinline__ void gemm_phase(PG8_LAS unsigned char* lds, const Gemm g, const Sched& S, const Epi& E, unsigned long long* stamps, const int wv_) {
    int tid_; asm volatile("v_mbcnt_lo_u32_b32 %0, -1, 0\n\tv_mbcnt_hi_u32_b32 %0, -1, %0" : "=v"(tid_)); tid_ += 64 * wv_; const int tid = tid_, wid = __builtin_amdgcn_readfirstlane(tid >> 6), lane = tid & 63, wr = wid >> 2, wc = wid & 3, fr = lane & 15, fq = lane >> 4;
    const int K = g.K, nt = K / BK;
    int ts_lo = 0, ts_hi = 0, nts = 0; const unsigned long long rt_entry = STAMP ? (unsigned long long)wall_clock64() : 0ull;
#define PG8_STAMP() do { if (STAMP && wid == 0 && nts < 64) { const unsigned long long _c = (unsigned long long)clock64(); \
        ts_lo = (lane == nts) ? (int)(unsigned)_c : ts_lo; ts_hi = (lane == nts) ? (int)(unsigned)(_c >> 32) : ts_hi; ++nts; } } while (0)
    PG8_STAMP();
    unsigned voffA[2], voffB[2];
#pragma unroll
    for (int i = 0; i < 2; ++i) { int R, C; stage_rc(tid * 16 + i * 8192, R, C); const int Rb = Epi::PERM ? ((R & ~31) + perm32(R & 31)) : R;
        voffA[i] = (unsigned)(R * K + C) * 2u; voffB[i] = (unsigned)(Rb * K + C) * 2u; }
    const size_t kstep = (size_t)(BK * 2);
    const size_t hstep = (size_t)HALF * K * 2;
    const size_t tstep = 2 * hstep;
    const unsigned ldsw = (unsigned)wid * 1024u;
    const int aoff = lds_byte(wr * 64 + fr, fq * 8), boff = lds_byte(wc * 32 + fr, fq * 8);
#define PG8_SA(b, h) (((b) * 2 + (h)) * HTB)
#define PG8_SB(b, h) ((4 + (b) * 2 + (h)) * HTB)
#define PG8_STAGE(bufoff, gbase, voff) do { _Pragma("unroll") for (int _i = 0; _i < 2; ++_i) \
        __builtin_amdgcn_global_load_lds((const unsigned*)((const char*)(gbase) + (voff)[_i]), (PG8_LAS unsigned*)(lds + (bufoff) + ldsw + _i * 8192), 16, 0, 0); } while (0)
#define PG8_LDA(dst, b, h) do { _Pragma("unroll") for (int m = 0; m < 4; ++m) _Pragma("unroll") for (int k = 0; k < 2; ++k) dst[m][k] = *(const PG8_LAS bf16x8*)(lds + PG8_SA(b, h) + aoff + m * 2048 + k * 1024); } while (0)
#define PG8_LDB(dst, b, h) do { _Pragma("unroll") for (int n = 0; n < 2; ++n) _Pragma("unroll") for (int k = 0; k < 2; ++k) dst[n][k] = *(const PG8_LAS bf16x8*)(lds + PG8_SB(b, h) + boff + n * 2048 + k * 1024); } while (0)
#define PG8_MMA(ai, bj, At, Bt) do { __builtin_amdgcn_s_setprio(1); _Pragma("unroll") for (int m = 0; m < 4; ++m) _Pragma("unroll") for (int n = 0; n < 2; ++n) _Pragma("unroll") for (int k = 0; k < 2; ++k) \
        acc[ai][bj][m][n] = __builtin_amdgcn_mfma_f32_16x16x32_bf16(Bt[n][k], At[m][k], acc[ai][bj][m][n], 0, 0, 0); __builtin_amdgcn_s_setprio(0); } while (0)
#define PG8_WAIT_V(n) asm volatile("s_waitcnt vmcnt(" #n ")" ::: "memory")
#define PG8_WAIT_L(n) asm volatile("s_waitcnt lgkmcnt(" #n ")" ::: "memory")
#define PG8_BAR __builtin_amdgcn_s_barrier()
#define PG8_SCHED __builtin_amdgcn_sched_barrier(0)
    Unit cur, nxt; int ui = 0;
    if (!S.next(0, cur)) return;
    f32x4 acc[2][2][4][2];
#pragma unroll
    for (int a = 0; a < 2; ++a)
#pragma unroll
        for (int b = 0; b < 2; ++b)
#pragma unroll
            for (int m = 0; m < 4; ++m)
#pragma unroll
                for (int n = 0; n < 2; ++n) acc[a][b][m][n] = (f32x4){0.f, 0.f, 0.f, 0.f};
    bf16x8 At[4][2], B0[2][2], B1[2][2];
    const char* cA = (const char*)g.A + (size_t)cur.pm * tstep; const char* cB = (const char*)g.Bt + (size_t)cur.pn * tstep;
    S.a_ready(cur);
    PG8_STAGE(PG8_SB(0, 0), cB, voffB); PG8_STAGE(PG8_SA(0, 0), cA, voffA); PG8_STAGE(PG8_SB(0, 1), cB + hstep, voffB); PG8_STAGE(PG8_SA(0, 1), cA + hstep, voffA);
    if (wr == 1) PG8_BAR;
    PG8_WAIT_V(4); PG8_BAR;
    PG8_STAGE(PG8_SB(1, 0), cB + kstep, voffB); PG8_STAGE(PG8_SA(1, 0), cA + kstep, voffA); PG8_STAGE(PG8_SB(1, 1), cB + hstep + kstep, voffB);
    PG8_WAIT_V(6); PG8_BAR;
    PG8_STAMP();
    for (;;) {
        const bool has_next = S.next(ui + 1, nxt);
        const char* nA = has_next ? (const char*)g.A + (size_t)nxt.pm * tstep : cA; const char* nB = has_next ? (const char*)g.Bt + (size_t)nxt.pn * tstep : cB;
        for (int t = 0; t < nt; t += 2) {
            const bool last = (t == nt - 2);
            const char* a1 = cA + (size_t)(t + 1) * kstep;
            const char* a2 = last ? nA : cA + (size_t)(t + 2) * kstep; const char* b2 = last ? nB : cB + (size_t)(t + 2) * kstep;
            const char* a3 = a2 + kstep; const char* b3 = b2 + kstep;
            if (last && has_next) S.a_ready(nxt);
            PG8_LDB(B0, 0, 0); PG8_SCHED; PG8_LDA(At, 0, 0); PG8_STAGE(PG8_SA(1, 1), a1 + hstep, voffA);
            PG8_WAIT_L(8); PG8_BAR; PG8_WAIT_L(0); PG8_MMA(0, 0, At, B0); PG8_BAR; PG8_SCHED;
            PG8_LDB(B1, 0, 1); PG8_STAGE(PG8_SB(0, 0), b2, voffB);
            PG8_BAR; PG8_WAIT_L(0); PG8_MMA(0, 1, At, B1); PG8_BAR;
            PG8_LDA(At, 0, 1); PG8_STAGE(PG8_SA(0, 0), a2, voffA);
            PG8_BAR; PG8_WAIT_L(0); PG8_MMA(1, 0, At, B0); PG8_BAR; PG8_SCHED;
            PG8_STAGE(PG8_SB(0, 1), b2 + hstep, voffB);
            PG8_WAIT_V(6); PG8_BAR; PG8_MMA(1, 1, At, B1); PG8_BAR;
            PG8_LDB(B0, 1, 0); PG8_SCHED; PG8_LDA(At, 1, 0); PG8_STAGE(PG8_SA(0, 1), a2 + hstep, voffA);
            PG8_WAIT_L(8); PG8_BAR; PG8_WAIT_L(0); PG8_MMA(0, 0, At, B0); PG8_BAR; PG8_SCHED;
            PG8_LDB(B1, 1, 1); PG8_STAGE(PG8_SB(1, 0), b3, voffB);
            PG8_BAR; PG8_WAIT_L(0); PG8_MMA(0, 1, At, B1); PG8_BAR;
            PG8_LDA(At, 1, 1); PG8_STAGE(PG8_SA(1, 0), a3, voffA);
            PG8_BAR; PG8_WAIT_L(0); PG8_MMA(1, 0, At, B0); PG8_BAR; PG8_SCHED;
            PG8_STAGE(PG8_SB(1, 1), b3 + hstep, voffB);
            PG8_WAIT_V(6); PG8_BAR; PG8_MMA(1, 1, At, B1); PG8_BAR;
        }
        PG8_STAMP();
        if constexpr (!Epi::AFTER_DRAIN) { PG8_EPI_T0; E(acc, cur, wr, wc, fr, fq); PG8_EPI_T1; S.done(cur); }
        PG8_STAMP();
        if (!has_next) break;
#pragma unroll
        for (int a = 0; a < 2; ++a)
#pragma unroll
            for (int b = 0; b < 2; ++b)
#pragma unroll
                for (int m = 0; m < 4; ++m)
#pragma unroll
                    for (int n = 0; n < 2; ++n) acc[a][b][m][n] = (f32x4){0.f, 0.f, 0.f, 0.f};
        cur = nxt; cA = nA; cB = nB; ++ui;
    }
    PG8_WAIT_V(0);
    if (wr == 0) PG8_BAR;
    PG8_BAR;
    if constexpr (Epi::AFTER_DRAIN) { E.fused(acc, cur, wr, wc, fr, fq, lds, wid, lane); S.done(cur); }
    PG8_STAMP();
    if (STAMP && wid == 0) { stamps[lane] = lane < nts ? (((unsigned long long)(unsigned)ts_hi << 32) | (unsigned)ts_lo) : 0ull;
        if (lane == 62) stamps[62] = rt_entry; if (lane == 63) stamps[63] = (unsigned long long)wall_clock64(); }
#undef PG8_STAMP
#undef PG8_SA
#undef PG8_SB
#undef PG8_STAGE
#undef PG8_LDA
#undef PG8_LDB
#undef PG8_MMA
#undef PG8_WAIT_V
#undef PG8_WAIT_L
#undef PG8_BAR
#undef PG8_SCHED
}
}

namespace cg = cooperative_groups;
#define LAS __attribute__((address_space(3)))
typedef unsigned short bf16;
typedef short bf16x8 __attribute__((ext_vector_type(8)));
typedef float f32x4 __attribute__((ext_vector_type(4)));
typedef unsigned u32x4 __attribute__((ext_vector_type(4)));
typedef unsigned u32x2 __attribute__((ext_vector_type(2)));
typedef float f32x2 __attribute__((ext_vector_type(2)));

constexpr int DM = 1024, NB = 8, SEQ = 8192, NTOK = NB * SEQ, CTXL = 256, NCTX = NB * CTXL, PROJW = 8192;
constexpr int NTHR = 512;
constexpr int LDS_BYTES = 160 * 1024;
constexpr float EPSF = 1e-6f;

constexpr size_t MiB = 1ull << 20, KiB = 1ull << 10;
constexpr size_t WS_WINT = 0, WS_WHYT = 16 * MiB, WS_WRETT = 18 * MiB, WS_WOT = 20 * MiB, WS_WQT = 22 * MiB;
constexpr size_t WS_KERN2 = 24 * MiB;
constexpr size_t WS_PU = 64 * MiB, WS_PV = 72 * MiB;
constexpr size_t WS_MISC = 88 * MiB;
constexpr size_t WS_MOD = WS_MISC, WS_ROT = WS_MISC + 256 * KiB, WS_GFEAT = WS_MISC + 512 * KiB, WS_KPART = WS_MISC + 3 * MiB,
                 WS_HCTX = WS_MISC + 5 * MiB, WS_CK = WS_MISC + 9 * MiB, WS_CV = WS_MISC + 11 * MiB;
constexpr size_t WS_A = 104 * MiB;
constexpr size_t WS_ZT = 232 * MiB;
constexpr size_t WS_X0T = 232 * MiB, WS_X1T = 360 * MiB, WS_VT = 488 * MiB;
constexpr size_t WS_QK = 616 * MiB, WS_V = 744 * MiB, WS_G = 872 * MiB, WS_END = 1004 * MiB;
constexpr size_t WS_FPIMG = WS_MISC + 15 * MiB, WS_FNAT = WS_MISC + 15 * MiB + 64 * KiB;
constexpr size_t WS_BAR = WS_MISC + 15 * MiB + 128 * KiB;
constexpr size_t WS_SUBK16 = WS_MISC + 15 * MiB + 256 * KiB;
constexpr size_t WS_FW4T = WS_MISC + 15 * MiB + 512 * KiB;
constexpr size_t WS_KPART2 = 1000 * MiB;
constexpr size_t WS_HBUF = WS_A;
constexpr size_t WS_X8 = WS_X1T + 64 * MiB;
constexpr size_t WS_YHT = WS_X1T, WS_YH = WS_X0T;
constexpr size_t WS_OF = WS_A, WS_OB = WS_VT, WS_M = WS_QK, WS_H2 = WS_VT, WS_QP = WS_G, WS_RIDX = WS_X1T, WS_RGATE = WS_X1T + 32 * MiB;

#define PG8_PROBE_PTR ((PROBE_SEC == 30 || PROBE_SEC == 31) ? (unsigned long long*)(ws + WS_BAR) : (unsigned long long*)nullptr)
struct Params {
    const float* in[31];
    float* out;
    unsigned char* ws;
};
#ifndef PROBE_SEC
#define PROBE_SEC (-1)
#endif
#define SEC_BEGIN(id) unsigned long long _sec_t0_##id = 0ull; if (PROBE_SEC == (id)) _sec_t0_##id = __builtin_amdgcn_s_memrealtime()
#define SEC_END(id, wsptr) do { if (PROBE_SEC == (id)) { const unsigned long long _dt = __builtin_amdgcn_s_memrealtime() - _sec_t0_##id; \
        if (threadIdx.x == 0) atomicAdd((unsigned long long*)((wsptr) + WS_BAR) + blockIdx.x, _dt); } } while (0)
enum { I_X = 0, I_C, I_CTX, I_CCTX, I_WADA, I_BADA, I_NORM1, I_NORM2, I_WIN, I_HCW, I_HCB, I_FW1, I_FB1, I_FW2, I_FB2, I_FW3, I_FB3, I_FW4, I_FREQ, I_DELTAS, I_HBIAS,
       I_LGF, I_LGB, I_WHY, I_WRET, I_WO, I_WQ, I_SUBK, I_PU, I_PV, I_FNORM };

typedef __bf16 hwbf16x2 __attribute__((ext_vector_type(2)));
typedef float hwf32x2 __attribute__((ext_vector_type(2)));
__device__ __forceinline__ unsigned pk2(float lo, float hi) { const hwf32x2 v = {lo, hi}; return __builtin_bit_cast(unsigned, __builtin_convertvector(v, hwbf16x2)); }
__device__ __forceinline__ unsigned f2bf(float f) { return pk2(f, f); }
__device__ __forceinline__ unsigned f2bf_sw(float f) { unsigned u = __float_as_uint(f); return (u + 0x7fffu + ((u >> 16) & 1u)) >> 16; }
__device__ __forceinline__ unsigned pk2_sw(float lo, float hi) { return f2bf_sw(lo) | (f2bf_sw(hi) << 16); }
__device__ __forceinline__ float bf_lo(unsigned w) { return __uint_as_float(w << 16); }
__device__ __forceinline__ float bf_hi(unsigned w) { return __uint_as_float(w & 0xffff0000u); }
__device__ __forceinline__ float bf1(bf16 h) { return __uint_as_float(((unsigned)h) << 16); }
__device__ __forceinline__ float wave_sum(float v) {
#pragma unroll
    for (int o = 1; o < 64; o <<= 1) v += __shfl_xor(v, o);
    return v;
}
__device__ __forceinline__ float wave_sum_dpp(float v) {
    v += __int_as_float(__builtin_amdgcn_update_dpp(0, __float_as_int(v), 0xB1, 0xF, 0xF, false));
    v += __int_as_float(__builtin_amdgcn_update_dpp(0, __float_as_int(v), 0x4E, 0xF, 0xF, false));
    v += __int_as_float(__builtin_amdgcn_update_dpp(0, __float_as_int(v), 0x141, 0xF, 0xF, false));
    v += __int_as_float(__builtin_amdgcn_update_dpp(0, __float_as_int(v), 0x140, 0xF, 0xF, false));
    v += __int_as_float(__builtin_amdgcn_update_dpp(0, __float_as_int(v), 0x142, 0xA, 0xF, false));
    v += __int_as_float(__builtin_amdgcn_update_dpp(0, __float_as_int(v), 0x143, 0xC, 0xF, false));
    return __int_as_float(__builtin_amdgcn_readlane(__float_as_int(v), 63));
}
__device__ __forceinline__ size_t gate_off(int row, int col) { return (size_t)(row >> 8) * 524288 + (size_t)(row & 255) * 1024 + col; }
__device__ __forceinline__ float sigmoidf_(float x) { return __builtin_amdgcn_rcpf(1.0f + __expf(-x)); }
__device__ __forceinline__ int opaque_tid(const int wv) { int l; asm volatile("v_mbcnt_lo_u32_b32 %0, -1, 0\n\tv_mbcnt_hi_u32_b32 %0, -1, %0" : "=v"(l)); return l + 64 * wv; }
__device__ __forceinline__ float rdlane(float v, int l) { return __int_as_float(__builtin_amdgcn_readlane(__float_as_int(v), l)); }


__device__ __forceinline__ void sincos_f(float x, float& s, float& c) {
    const float k = rintf(x * 0.636619772367581343f);
    const int qd = (int)k;
    float r = fmaf(-k, 1.57079625129699707031e+00f, x);
    r = fmaf(-k, 7.54978941586159635335e-08f, r);
    r = fmaf(-k, 5.39030295347424192935e-15f, r);
    const float r2 = r * r;
    const float sp = r + r * r2 * (-1.6666654611e-1f + r2 * (8.3321608736e-3f - r2 * 1.9515295891e-4f));
    const float cp = 1.0f - 0.5f * r2 + r2 * r2 * (4.166664568298827e-2f + r2 * (-1.388731625493765e-3f + r2 * 2.443315711809948e-5f));
    const float s1 = (qd & 1) ? cp : sp, c1 = (qd & 1) ? sp : cp;
    s = (qd & 2) ? -s1 : s1;
    c = ((qd + 1) & 2) ? -c1 : c1;
}
__device__ __forceinline__ float sin_f(float x) { float s, c; sincos_f(x, s, c); return s; }

__device__ __forceinline__ int win_dst_row(int n) {
    if (n >= 3072 && n < 4096) { const int e = n & 63; const int pp = (e < 32) ? (8 * (e >> 2) + (e & 3)) : (8 * ((e - 32) >> 2) + 4 + (e & 3)); return (n & ~63) + pp; }
    return n;
}
__device__ __forceinline__ void transpose_item(const float* __restrict__ W, int K, int N, bf16* __restrict__ WT, LAS float* scr, int item, int lane, bool permute) {
    const int nblk = N / 32, kb = item / nblk, nb = item % nblk, k0 = 64 * kb, n0 = 32 * nb;
#pragma unroll 8
    for (int i = 0; i < 32; ++i) { const int kk = 2 * i + (lane >> 5); scr[kk * 33 + (lane & 31)] = W[(size_t)(k0 + kk) * N + n0 + (lane & 31)]; }
    __builtin_amdgcn_s_waitcnt(0xC07F); asm volatile("" ::: "memory");
    const int c = lane & 7;
#pragma unroll
    for (int j = 0; j < 4; ++j) { const int n = (lane >> 3) + 8 * j; const LAS float* s = scr + (8 * c) * 33 + n;
        u32x4 o; o.x = pk2(s[0 * 33], s[1 * 33]); o.y = pk2(s[2 * 33], s[3 * 33]); o.z = pk2(s[4 * 33], s[5 * 33]); o.w = pk2(s[6 * 33], s[7 * 33]);
        const int nd = permute ? win_dst_row(n0 + n) : (n0 + n);
        *(u32x4*)(WT + (size_t)nd * K + k0 + 8 * c) = o; }
    __builtin_amdgcn_s_waitcnt(0xC07F); asm volatile("" ::: "memory");
}

__device__ __forceinline__ void ph0_prologue(const int wv, const Params& p, unsigned char* smem) {
    const int tid = opaque_tid(wv), lane = tid & 63, wave = __builtin_amdgcn_readfirstlane(tid >> 6);
    const bool split = gridDim.x > 96 + 32;
    const int vb = split ? (int)blockIdx.x - 96 : (int)blockIdx.x, NVB = split ? (int)gridDim.x - 96 : (int)gridDim.x;
    const int gw = vb * 8 + wave, NGW = NVB * 8;
    unsigned char* ws = p.ws;
#ifndef P0M
#define P0M 15
#endif
#if P0M & 1
    {
        LAS float* st = (LAS float*)(LAS unsigned char*)smem;
        LAS float* red = (LAS float*)((LAS unsigned char*)smem + 36864);
        float* mod = (float*)(ws + WS_MOD);
        const float* wada = p.in[I_WADA];
        for (int item = blockIdx.x; item < 96; item += gridDim.x) {
            for (int i = tid; i < 9 * 1024; i += NTHR) { const int r = i >> 10, k = i & 1023; const float v = (r < 8) ? p.in[I_C][r * 1024 + k] : p.in[I_CCTX][k]; st[i] = v / (1.0f + __expf(-v)); }
            __syncthreads();
            const int j = item * 64 + lane;
            float acc[9];
#pragma unroll
            for (int r = 0; r < 9; ++r) acc[r] = 0.f;
            const int k0 = wave * 128;
#pragma unroll 32
            for (int k = k0; k < k0 + 128; ++k) { const float w = wada[(size_t)k * 6144 + j];
#pragma unroll
                for (int r = 0; r < 9; ++r) acc[r] += st[r * 1024 + k] * w; }
#pragma unroll
            for (int r = 0; r < 9; ++r) red[(wave * 9 + r) * 64 + lane] = acc[r];
            __syncthreads();
            for (int o = tid; o < 576; o += NTHR) { const int r = o >> 6, l = o & 63; float s = p.in[I_BADA][item * 64 + l];
#pragma unroll
                for (int w = 0; w < 8; ++w) s += red[(w * 9 + r) * 64 + l];
                mod[r * 6144 + item * 64 + l] = s; }
            __syncthreads();
        }
    }
#endif
#if P0M & 2
    {
        float2* rot = (float2*)(ws + WS_ROT);
        const int gt = vb >= 0 ? vb * NTHR + tid : 0x7fffffff;
        if (gt < 4096) { const int pos = gt >> 5, f = gt & 31; const float inv = exp2f(-(float)f * (13.287712379549449f / 32.0f)); const float ang = (float)pos * inv; float sn, cs_; sincos_f(ang, sn, cs_); rot[gt] = make_float2(cs_, sn); }
    }
#endif
#if P0M & 4
    {
        const int gt = vb >= 0 ? vb * NTHR + tid : 0x7fffffff;
        for (int g2 = gt; g2 < 131072 && g2 >= 0; g2 += NVB * NTHR) { const int cc = g2 >> 6, jj = g2 & 63; ((bf16*)(ws + WS_FW4T))[g2] = (bf16)f2bf(p.in[I_FW4][(size_t)jj * 2048 + cc]); }
        if (gt < 131072 / 8) { const f32x4 a = *(const f32x4*)(p.in[I_SUBK] + 8 * gt), b2 = *(const f32x4*)(p.in[I_SUBK] + 8 * gt + 4);
            u32x4 o; o.x = pk2(a.x, a.y); o.y = pk2(a.z, a.w); o.z = pk2(b2.x, b2.y); o.w = pk2(b2.z, b2.w); *(u32x4*)((bf16*)(ws + WS_SUBK16) + 8 * gt) = o; }
        if (gt < 16384) { const int row = gt >> 7, col = gt & 127;
            bf16* fnat = (bf16*)(ws + WS_FNAT); bf16* fimg = (bf16*)(ws + WS_FPIMG);
            { float sn, cs_; sincos_f(0.04908738521234052f * (float)((row * col) & 127), sn, cs_); fnat[gt] = (bf16)f2bf(cs_); fnat[16384 + gt] = (bf16)f2bf(-sn); }
            { const int ks_ = col >> 5, qq = (col >> 3) & 3, jj = col & 7; const int kc = 32 * ks_ + (jj < 4 ? 4 * qq + jj : 16 + 4 * qq + (jj - 4));
              float sn, cs_; sincos_f(0.04908738521234052f * (float)((row * kc) & 127), sn, cs_);
              const int off = (row * 256 + ((((col >> 3) ^ ((row ^ (row >> 3)) & 15))) << 4) + ((col & 7) << 1)) >> 1;
              fimg[off] = (bf16)f2bf(cs_); fimg[16384 + off] = (bf16)f2bf(-sn); }
        }
    }
    {
        const float *fw1 = p.in[I_FW1], *fb1 = p.in[I_FB1], *fw2 = p.in[I_FW2], *fb2 = p.in[I_FB2], *fw3 = p.in[I_FW3], *fb3 = p.in[I_FB3], *freq = p.in[I_FREQ];
        float* gfeat = (float*)(ws + WS_GFEAT);
        const float fq = freq[lane];
        LAS float* hb = (LAS float*)((LAS unsigned char*)smem + 65536 + wave * 1024);
        for (int t0 = vb >= 0 ? gw * 4 : SEQ; t0 < SEQ; t0 += NGW * 4) {
            float a[4];
#pragma unroll
            for (int u = 0; u < 4; ++u) { const int t = t0 + u;
                const float tl = (float)t / 8191.0f;
                const float w = 7.66990393942820614859e-4f * (float)t;
                float zz = 0.f;
                if (lane == 0) zz = tl;
                else if (lane <= 16) { const float band = 1e-4f + (float)(lane - 1) * ((15.0f - 1e-4f) / 15.0f); float sn, cs_; sincos_f(band * w, sn, cs_); zz = cs_; }
                else if (lane <= 32) { const float band = 1e-4f + (float)(lane - 17) * ((15.0f - 1e-4f) / 15.0f); zz = -sin_f(band * w); }
                hb[u * 64 + lane] = zz; a[u] = fb1[lane]; }
            __builtin_amdgcn_s_waitcnt(0xC07F); asm volatile("" ::: "memory");
#pragma unroll 11
            for (int i = 0; i < 33; ++i) { const float wv = fw1[i * 64 + lane];
#pragma unroll
                for (int u = 0; u < 4; ++u) a[u] += hb[u * 64 + i] * wv; }
            asm volatile("" ::: "memory");
#pragma unroll
            for (int u = 0; u < 4; ++u) { hb[u * 64 + lane] = sin_f(fq * a[u]); a[u] = fb2[lane]; }
            __builtin_amdgcn_s_waitcnt(0xC07F); asm volatile("" ::: "memory");
#pragma unroll 16
            for (int i = 0; i < 64; ++i) { const float wv = fw2[i * 64 + lane];
#pragma unroll
                for (int u = 0; u < 4; ++u) a[u] += hb[u * 64 + i] * wv; }
            asm volatile("" ::: "memory");
#pragma unroll
            for (int u = 0; u < 4; ++u) { hb[u * 64 + lane] = sin_f(fq * a[u]); a[u] = fb3[lane]; }
            __builtin_amdgcn_s_waitcnt(0xC07F); asm volatile("" ::: "memory");
#pragma unroll 16
            for (int i = 0; i < 64; ++i) { const float wv = fw3[i * 64 + lane];
#pragma unroll
                for (int u = 0; u < 4; ++u) a[u] += hb[u * 64 + i] * wv; }
            asm volatile("" ::: "memory");
#pragma unroll
            for (int u = 0; u < 4; ++u) ((bf16*)gfeat)[(t0 + u) * 64 + lane] = (bf16)f2bf(sin_f(fq * a[u]));
        }
    }
#endif
#if P0M & 8
    __syncthreads();
    {
        LAS float* scr = (LAS float*)((LAS unsigned char*)smem + wave * 8448);
        constexpr int I_IN = 16 * 256, I_SQ = 16 * 32;
        constexpr int NITEMS = I_IN + 4 * I_SQ;
        for (int it = vb >= 0 ? gw : NITEMS; it < NITEMS; it += NGW) {
            int r = it;
            if (r < I_IN) { transpose_item(p.in[I_WIN], 1024, 8192, (bf16*)(ws + WS_WINT), scr, r, lane, true); continue; } r -= I_IN;
            if (r < I_SQ) { transpose_item(p.in[I_WHY], 1024, 1024, (bf16*)(ws + WS_WHYT), scr, r, lane, false); continue; } r -= I_SQ;
            if (r < I_SQ) { transpose_item(p.in[I_WRET], 1024, 1024, (bf16*)(ws + WS_WRETT), scr, r, lane, false); continue; } r -= I_SQ;
            if (r < I_SQ) { transpose_item(p.in[I_WO], 1024, 1024, (bf16*)(ws + WS_WOT), scr, r, lane, false); continue; } r -= I_SQ;
            transpose_item(p.in[I_WQ], 1024, 1024, (bf16*)(ws + WS_WQT), scr, r, lane, false);
        }
    }
#endif
}

__device__ __forceinline__ void norm_mod_row(const float* xr, const float* gain, const float* shift, const float* scale, bf16* dst, int lane) {
    f32x4 v[4]; float ss = 0.f;
#pragma unroll
    for (int j = 0; j < 4; ++j) { v[j] = *(const f32x4*)(xr + 4 * lane + 256 * j); ss += (v[j].x * v[j].x + v[j].y * v[j].y) + (v[j].z * v[j].z + v[j].w * v[j].w); }
    ss = wave_sum(ss);
    const float rs = 1.0f / sqrtf(ss * (1.0f / 1024.0f) + EPSF);
#pragma unroll
    for (int j = 0; j < 4; ++j) { const int c0 = 4 * lane + 256 * j;
        const f32x4 n = *(const f32x4*)(gain + c0), sc = *(const f32x4*)(scale + c0), sh = *(const f32x4*)(shift + c0);
        const f32x4 y = v[j] * rs * n * (sc + 1.0f) + sh;
        u32x2 o; o.x = pk2(y.x, y.y); o.y = pk2(y.z, y.w);
        *(u32x2*)(dst + c0) = o; }
}

__device__ __forceinline__ void ph1_rows_and_taps(const int wv, const Params& p, unsigned char* smem) {
    const int tid = opaque_tid(wv), lane = tid & 63, wave = __builtin_amdgcn_readfirstlane(tid >> 6);
    const int gw = blockIdx.x * 8 + wave, NGW = gridDim.x * 8;
    unsigned char* ws = p.ws;
    const float* mod = (const float*)(ws + WS_MOD);
    const int r16 = lane & 15, q = lane >> 4;
    const bf16* gf16 = (const bf16*)(ws + WS_GFEAT); const bf16* fw4t = (const bf16*)(ws + WS_FW4T);
    bf16* kern2 = (bf16*)(ws + WS_KERN2); float* kpart = (float*)(ws + WS_KPART2);
    int un = gw; bool has = un < 2048;
    u32x4 A0 = (u32x4){0u, 0u, 0u, 0u}, A1 = A0, Bn0 = A0, Bn1 = A0; float dn = 0.f; int tt = 0, cq = 0, t0 = 0, ct = 0;
#define TAPS_PREF(c_) do { const int cp_ = 512 * cq + 16 * (c_) + r16; Bn0 = *(const u32x4*)(fw4t + (size_t)cp_ * 64 + 8 * q); Bn1 = *(const u32x4*)(fw4t + (size_t)cp_ * 64 + 32 + 8 * q); dn = p.in[I_DELTAS][cp_ & 1023]; } while (0)
#define TAPS_SETUP() do { tt = un >> 2; cq = un & 3; A0 = *(const u32x4*)(gf16 + (size_t)(16 * tt + r16) * 64 + 8 * q); A1 = *(const u32x4*)(gf16 + (size_t)(16 * tt + r16) * 64 + 32 + 8 * q); t0 = 16 * tt + 4 * q; ct = 0; TAPS_PREF(0); } while (0)
#define TAPS_STEP() do { const int cp = 512 * cq + 16 * ct + r16, c = cp & 1023; const bool bwd = cp >= 1024; const u32x4 B0 = Bn0, B1 = Bn1; const float dl = dn; \
        if (ct + 1 < 32) TAPS_PREF(ct + 1); \
        f32x4 acc = (f32x4){0.f, 0.f, 0.f, 0.f}; \
        acc = __builtin_amdgcn_mfma_f32_16x16x32_bf16(__builtin_bit_cast(bf16x8, A0), __builtin_bit_cast(bf16x8, B0), acc, 0, 0, 0); \
        acc = __builtin_amdgcn_mfma_f32_16x16x32_bf16(__builtin_bit_cast(bf16x8, A1), __builtin_bit_cast(bf16x8, B1), acc, 0, 0, 0); \
        const float ad = fabsf(dl) * (1.0f / 8191.0f); \
        const float e0 = expf(-(float)t0 * ad), st = expf(-ad); \
        f32x4 o; float part = 0.f, e = e0; \
        _Pragma("unroll") for (int r = 0; r < 4; ++r) { const float val = acc[r] * e; e *= st; o[r] = val; if (!bwd || t0 + r > 0) part += fabsf(val); } \
        { u32x2 o2; o2.x = pk2(o[0], o[1]); o2.y = pk2(o[2], o[3]); *(u32x2*)(kern2 + (size_t)c * 16384 + (bwd ? 8192 : 0) + t0) = o2; } \
        part += __shfl_xor(part, 16); part += __shfl_xor(part, 32); \
        if (q == 0) kpart[(size_t)tt * 2048 + cp] = part; \
        ++ct; } while (0)
    if (has) TAPS_SETUP();
    {
        f32x4 vn[4], gsc[4], sh[4]; int cur_b = -1;
#pragma unroll
        for (int j = 0; j < 4; ++j) { gsc[j] = (f32x4){0.f, 0.f, 0.f, 0.f}; sh[j] = gsc[j]; }
        { const int r = gw; const float* xr = r >= NTOK ? p.in[I_CTX] + (size_t)(r - NTOK) * 1024 : p.in[I_X] + (size_t)r * 1024;
#pragma unroll
          for (int j = 0; j < 4; ++j) vn[j] = *(const f32x4*)(xr + 4 * lane + 256 * j); }
        for (int r = gw; r < NTOK + NCTX; r += NGW) {
            if (has && ct < 32) TAPS_STEP();
            const bool isc = r >= NTOK;
            const float* md = mod + (isc ? 8 : (r >> 13)) * 6144;
            bf16* dst = isc ? (bf16*)(ws + WS_HCTX) + (size_t)(r - NTOK) * 1024 : (bf16*)(ws + WS_A) + (size_t)r * 1024;
            f32x4 v[4];
#pragma unroll
            for (int j = 0; j < 4; ++j) v[j] = vn[j];
            { const int bsel = isc ? 8 : (r >> 13);
              if (bsel != cur_b) { cur_b = bsel;
#pragma unroll
                  for (int j = 0; j < 4; ++j) { const int c0 = 4 * lane + 256 * j; gsc[j] = *(const f32x4*)(p.in[I_NORM1] + c0) * (*(const f32x4*)(md + 1024 + c0) + 1.0f); sh[j] = *(const f32x4*)(md + c0); } } }
            asm volatile("" ::: "memory");
            { const int rn = (r + NGW < NTOK + NCTX) ? r + NGW : r; const float* xr = rn >= NTOK ? p.in[I_CTX] + (size_t)(rn - NTOK) * 1024 : p.in[I_X] + (size_t)rn * 1024;
#pragma unroll
              for (int j = 0; j < 4; ++j) vn[j] = *(const f32x4*)(xr + 4 * lane + 256 * j); }
            asm volatile("" ::: "memory");
            float ss = 0.f;
#pragma unroll
            for (int j = 0; j < 4; ++j) ss += (v[j].x * v[j].x + v[j].y * v[j].y) + (v[j].z * v[j].z + v[j].w * v[j].w);
            ss = wave_sum(ss);
            const float rs = 1.0f / sqrtf(ss * (1.0f / 1024.0f) + EPSF);
#pragma unroll
            for (int j = 0; j < 4; ++j) { const int c0 = 4 * lane + 256 * j;
                const f32x4 y = v[j] * rs * gsc[j] + sh[j];
                u32x2 o; o.x = pk2(y.x, y.y); o.y = pk2(y.z, y.w);
                *(u32x2*)(dst + c0) = o; }
        }
    }
    while (has) {
        while (ct < 32) TAPS_STEP();
        un += NGW; has = un < 2048;
        if (has) TAPS_SETUP();
    }
#undef TAPS_PREF
#undef TAPS_SETUP
#undef TAPS_STEP
}

struct EpiInProj {
    static constexpr bool PERM = true, AFTER_DRAIN = false;
    bf16* zT; bf16* QK; bf16* VG; bf16* AHR; const float2* rot;
    __device__ __forceinline__ void operator()(const pg8::f32x4 (&acc)[2][2][4][2], const pg8::Unit& u, int wr, int wc, int fr, int fq) const {
        const int pn = u.pn;
        const int row0 = u.pm * 256 + wr * 64 + fr;
        const int colw = wc * 32 + 8 * fq;
#ifndef EPM
#define EPM 7
#endif
        if ((EPM & 1) && pn < 12) {
            SEC_BEGIN(32);
            const int sec = pn >> 2, cbase = (pn & 3) * 256;
#pragma unroll
            for (int ai = 0; ai < 2; ++ai)
#pragma unroll
                for (int m = 0; m < 4; ++m) { const int row = row0 + ai * 128 + m * 16; const int b = row >> 13, t = row & 8191;
#pragma unroll
                    for (int bj = 0; bj < 2; ++bj) { const int c = cbase + bj * 128 + colw;
                        bf16* dst = zT + ((size_t)((sec * NB + b) * 1024 + c)) * SEQ + t;
#pragma unroll
                        for (int n = 0; n < 2; ++n)
#pragma unroll
                            for (int j = 0; j < 4; ++j) dst[(size_t)(4 * n + j) * SEQ] = (bf16)f2bf(acc[ai][bj][m][n][j]); }
                    asm volatile("" ::: "memory"); }
            SEC_END(32, (unsigned char*)zT - WS_ZT);
        } else if ((EPM & 2) && pn < 16) {
            const float scale = (pn >= 14) ? 0.08838834764831845f : 1.0f;
#pragma unroll
            for (int ai = 0; ai < 2; ++ai)
#pragma unroll
                for (int m = 0; m < 4; ++m) { const int row = row0 + ai * 128 + m * 16; const int t = row & 8191; const int prow = t >> 6, pcol = t & 63;
#pragma unroll
                    for (int bj = 0; bj < 2; ++bj) { const int cc = (pn - 12) * 256 + bj * 128 + colw;
                        const int half = (cc >> 6) & 1, g = (cc & 63) >> 3; const int pos = half ? pcol : prow;
                        const float2* rp = rot + pos * 32 + 4 * g;
                        float o1[4], o2[4];
#pragma unroll
                        for (int j = 0; j < 4; ++j) { const float2 cs = rp[j]; const float x1 = acc[ai][bj][m][0][j], x2 = acc[ai][bj][m][1][j];
                            o1[j] = (x1 * cs.x - x2 * cs.y) * scale; o2[j] = (x1 * cs.y + x2 * cs.x) * scale; }
                        bf16* dst = QK + (size_t)row * 1024 + (cc & ~63) + 4 * g;
                        u32x2 a, b2; a.x = pk2(o1[0], o1[1]); a.y = pk2(o1[2], o1[3]); b2.x = pk2(o2[0], o2[1]); b2.y = pk2(o2[2], o2[3]);
                        *(u32x2*)dst = a; *(u32x2*)(dst + 32) = b2; }
                    asm volatile("" ::: "memory"); }
        } else if (EPM & 4) {
            const bool isg = pn >= 24;
            bf16* base = isg ? AHR + (size_t)((pn >> 2) & 1) * 262144 : VG + (size_t)((pn >> 2) & 1) * ((size_t)NTOK * 1024);
            const int act = pn < 20 ? 0 : (pn < 24 ? 1 : 2);
#pragma unroll
            for (int ai = 0; ai < 2; ++ai)
#pragma unroll
                for (int m = 0; m < 4; ++m) { const int row = row0 + ai * 128 + m * 16;
#pragma unroll
                    for (int bj = 0; bj < 2; ++bj) { const int cc = (pn & 3) * 256 + bj * 128 + colw;
                        float v[8];
#pragma unroll
                        for (int n = 0; n < 2; ++n)
#pragma unroll
                            for (int j = 0; j < 4; ++j) { const float x = acc[ai][bj][m][n][j]; const float sg = sigmoidf_(x); v[4 * n + j] = act == 0 ? x : (act == 1 ? x * sg : sg); }
                        u32x4 w; w.x = pk2(v[0], v[1]); w.y = pk2(v[2], v[3]); w.z = pk2(v[4], v[5]); w.w = pk2(v[6], v[7]);
                        *(u32x4*)(base + (isg ? gate_off(row, cc) : (size_t)row * 1024 + cc)) = w; }
                    asm volatile("" ::: "memory"); }
        }
    }
};
struct EpiCtx {
    static constexpr bool PERM = true, AFTER_DRAIN = false;
    bf16* CK; bf16* CV;
    __device__ __forceinline__ void operator()(const pg8::f32x4 (&acc)[2][2][4][2], const pg8::Unit& u, int wr, int wc, int fr, int fq) const {
        const int pn = u.pn;
        const int row0 = u.pm * 256 + wr * 64 + fr;
        const int colw = wc * 32 + 8 * fq;
#pragma unroll
        for (int ai = 0; ai < 2; ++ai)
#pragma unroll
            for (int m = 0; m < 4; ++m) { const int row = row0 + ai * 128 + m * 16;
#pragma unroll
                for (int bj = 0; bj < 2; ++bj) {
                    if (pn < 2) { const int cc = pn * 256 + bj * 128 + colw; const int g = (cc & 63) >> 3; const float scale = 0.08838834764831845f;
                        bf16* dst = CK + (size_t)row * 512 + (cc & ~63) + 4 * g;
                        u32x2 a, b2; a.x = pk2(acc[ai][bj][m][0][0] * scale, acc[ai][bj][m][0][1] * scale); a.y = pk2(acc[ai][bj][m][0][2] * scale, acc[ai][bj][m][0][3] * scale);
                        b2.x = pk2(acc[ai][bj][m][1][0] * scale, acc[ai][bj][m][1][1] * scale); b2.y = pk2(acc[ai][bj][m][1][2] * scale, acc[ai][bj][m][1][3] * scale);
                        *(u32x2*)dst = a; *(u32x2*)(dst + 32) = b2;
                    } else { const int cc = (pn - 2) * 256 + bj * 128 + colw;
                        u32x4 w; w.x = pk2(acc[ai][bj][m][0][0], acc[ai][bj][m][0][1]); w.y = pk2(acc[ai][bj][m][0][2], acc[ai][bj][m][0][3]);
                        w.z = pk2(acc[ai][bj][m][1][0], acc[ai][bj][m][1][1]); w.w = pk2(acc[ai][bj][m][1][2], acc[ai][bj][m][1][3]);
                        *(u32x4*)(CV + (size_t)row * 1024 + cc) = w; } } }
    }
};
template <int PASS> struct EpiMerge {
    static constexpr bool PERM = true, AFTER_DRAIN = false;
    bf16* Mo; const bf16* gate;
    __device__ __forceinline__ void operator()(const pg8::f32x4 (&acc)[2][2][4][2], const pg8::Unit& u, int wr, int wc, int fr, int fq) const {
        int fro = fr; asm volatile("" : "+v"(fro));
        const int row0 = u.pm * 256 + wr * 64 + fro; const int col0 = u.pn * 256 + wc * 32 + 8 * fq;
#pragma unroll
        for (int ai = 0; ai < 2; ++ai)
#pragma unroll
            for (int mh = 0; mh < 1; ++mh) {
                u32x4 gw[4][2], pw[4][2];
#pragma unroll
                for (int mm = 0; mm < 4; ++mm)
#pragma unroll
                    for (int bj = 0; bj < 2; ++bj) { gw[mm][bj] = *(const u32x4*)(gate + gate_off(row0 + ai * 128 + (4 * mh + mm) * 16, col0 + bj * 128));
                        if (PASS == 1) pw[mm][bj] = *(const u32x4*)(Mo + (size_t)(row0 + ai * 128 + (4 * mh + mm) * 16) * 1024 + col0 + bj * 128); }
#pragma unroll
                for (int mm = 0; mm < 4; ++mm) { const int m = 4 * mh + mm; const size_t ro = (size_t)(row0 + ai * 128 + m * 16) * 1024 + col0;
#pragma unroll
                    for (int bj = 0; bj < 2; ++bj) { const u32x4 g4 = gw[mm][bj];
                        float v[8];
                        v[0] = acc[ai][bj][m][0][0] * bf_lo(g4.x); v[1] = acc[ai][bj][m][0][1] * bf_hi(g4.x); v[2] = acc[ai][bj][m][0][2] * bf_lo(g4.y); v[3] = acc[ai][bj][m][0][3] * bf_hi(g4.y);
                        v[4] = acc[ai][bj][m][1][0] * bf_lo(g4.z); v[5] = acc[ai][bj][m][1][1] * bf_hi(g4.z); v[6] = acc[ai][bj][m][1][2] * bf_lo(g4.w); v[7] = acc[ai][bj][m][1][3] * bf_hi(g4.w);
                        if (PASS == 1) { const u32x4 p4 = pw[mm][bj];
                            v[0] += bf_lo(p4.x); v[1] += bf_hi(p4.x); v[2] += bf_lo(p4.y); v[3] += bf_hi(p4.y); v[4] += bf_lo(p4.z); v[5] += bf_hi(p4.z); v[6] += bf_lo(p4.w); v[7] += bf_hi(p4.w); }
                        u32x4 w; w.x = pk2(v[0], v[1]); w.y = pk2(v[2], v[3]); w.z = pk2(v[4], v[5]); w.w = pk2(v[6], v[7]);
                        *(u32x4*)(Mo + ro + bj * 128) = w; } }
            }
    }
};
struct EpiY {
    static constexpr bool PERM = true, AFTER_DRAIN = false;
    bf16* Y; const float* mod;
    __device__ __forceinline__ void operator()(const pg8::f32x4 (&acc)[2][2][4][2], const pg8::Unit& u, int wr, int wc, int fr, int fq) const {
        int fro = fr; asm volatile("" : "+v"(fro));
        const int row0 = u.pm * 256 + wr * 64 + fro, col0 = u.pn * 256 + wc * 32 + 8 * fq;
        const int b = (u.pm * 256) >> 13;
        f32x4 gv[2][2];
#pragma unroll
        for (int bj = 0; bj < 2; ++bj)
#pragma unroll
            for (int n = 0; n < 2; ++n) gv[bj][n] = *(const f32x4*)(mod + b * 6144 + 2048 + col0 + bj * 128 + 4 * n);
#pragma unroll
        for (int ai = 0; ai < 2; ++ai)
#pragma unroll
            for (int m = 0; m < 4; ++m) { const size_t ro = (size_t)(row0 + ai * 128 + m * 16) * 1024 + col0;
#pragma unroll
                for (int bj = 0; bj < 2; ++bj) { const f32x4 v0 = acc[ai][bj][m][0] * gv[bj][0], v1 = acc[ai][bj][m][1] * gv[bj][1];
                    u32x4 w; w.x = pk2(v0[0], v0[1]); w.y = pk2(v0[2], v0[3]); w.z = pk2(v1[0], v1[1]); w.w = pk2(v1[2], v1[3]);
                    *(u32x4*)(Y + ro + bj * 128) = w; } }
    }
};
struct EpiResid {
    static constexpr bool PERM = false, AFTER_DRAIN = false;
    const float* x; float* out; const float* mod;
    __device__ __forceinline__ void operator()(const pg8::f32x4 (&acc)[2][2][4][2], const pg8::Unit& u, int wr, int wc, int fr, int fq) const {
        int fro = fr; asm volatile("" : "+v"(fro));
        const int row0 = u.pm * 256 + wr * 64 + fro, col0 = u.pn * 256 + wc * 32 + 4 * fq;
        const int b = (u.pm * 256) >> 13;
        f32x4 gv[2][2];
#pragma unroll
        for (int bj = 0; bj < 2; ++bj)
#pragma unroll
            for (int n = 0; n < 2; ++n) gv[bj][n] = *(const f32x4*)(mod + b * 6144 + 2048 + col0 + bj * 128 + n * 16);
#pragma unroll
        for (int ai = 0; ai < 2; ++ai)
#pragma unroll
            for (int mh = 0; mh < 2; ++mh) {
                f32x4 xv[2][2][2];
#pragma unroll
                for (int mm = 0; mm < 2; ++mm)
#pragma unroll
                    for (int bj = 0; bj < 2; ++bj)
#pragma unroll
                        for (int n = 0; n < 2; ++n) xv[mm][bj][n] = *(const f32x4*)(x + (size_t)(row0 + ai * 128 + (2 * mh + mm) * 16) * 1024 + col0 + bj * 128 + n * 16);
#pragma unroll
                for (int mm = 0; mm < 2; ++mm) { const int m = 2 * mh + mm; const size_t ro = (size_t)(row0 + ai * 128 + m * 16) * 1024 + col0;
#pragma unroll
                    for (int bj = 0; bj < 2; ++bj)
#pragma unroll
                        for (int n = 0; n < 2; ++n) *(f32x4*)(out + ro + bj * 128 + n * 16) = xv[mm][bj][n] + gv[bj][n] * acc[ai][bj][m][n]; }
            }
    }
};

__device__ __forceinline__ void unpack8(const u32x4 v, float (&o)[8]);
typedef u32x4 frag_t;
__device__ __forceinline__ bf16x8 asbf(frag_t f) { return __builtin_bit_cast(bf16x8, f); }
__device__ __forceinline__ frag_t fneg(frag_t f) { return f ^ 0x80008000u; }
__device__ __forceinline__ unsigned xs_off(int row, int col) { return (unsigned)(row * 256 + ((((col >> 3) ^ ((row ^ (row >> 3)) & 15))) << 4) + ((col & 7) << 1)); }
#define MFMA16(a, b, c) __builtin_amdgcn_mfma_f32_16x16x32_bf16(asbf(a), asbf(b), c, 0, 0, 0)
constexpr int FFT_FP_RE = 0, FFT_FP_IM = 32768, FFT_XS = 65536, FFT_VB_RE = 98304, FFT_VB_IM = 131072;

__device__ __forceinline__ void fft_load_tables(const Params& p, LAS unsigned char* lds, int tid) {
    const u32x4* src = (const u32x4*)(p.ws + WS_FPIMG);
#pragma unroll
    for (int k = 0; k < 8; ++k) *(LAS u32x4*)(lds + FFT_FP_RE + (tid + 512 * k) * 16) = src[tid + 512 * k];
}
__device__ __forceinline__ void ph3a_filter_spectrum(const int wv, const Params& p, unsigned char* smem) {
    const int tid = opaque_tid(wv), lane = tid & 63, w = __builtin_amdgcn_readfirstlane(tid >> 6), r16 = lane & 15, q = lane >> 4;
    LAS unsigned char* lds = (LAS unsigned char*)smem;
    unsigned char* ws = p.ws;
    const bf16* kern2 = (const bf16*)(ws + WS_KERN2); const float* kpart = (const float*)(ws + WS_KPART2);
    float* hbuf = (float*)(ws + WS_HBUF);
    LAS float* red = (LAS float*)(lds + FFT_VB_RE);
    fft_load_tables(p, lds, tid);
    const int k1 = 16 * w + r16;
    unsigned fo[4];
#pragma unroll
    for (int ks_ = 0; ks_ < 4; ++ks_) fo[ks_] = (unsigned)(r16 * 256 + ((((4 * ks_ + q) ^ ((r16 ^ (r16 >> 3)) & 15))) << 4));
    frag_t Bre[4], Bim[4];
    { const bf16* fn = (const bf16*)(ws + WS_FNAT);
#pragma unroll
      for (int ks_ = 0; ks_ < 4; ++ks_) { Bre[ks_] = *(const frag_t*)(fn + k1 * 128 + 32 * ks_ + 8 * q); Bim[ks_] = *(const frag_t*)(fn + 16384 + k1 * 128 + 32 * ks_ + 8 * q); } }
    float cb[4], sb[4], cd, sd;
#pragma unroll
    for (int r = 0; r < 4; ++r) sincos_f(3.8349519697141029e-4f * (float)(k1 * (4 * q + r)), sb[r], cb[r]);
    sincos_f(3.8349519697141029e-4f * (float)(k1 * 16), sd, cd);
    const int cper = (1024 + (int)gridDim.x - 1) / (int)gridDim.x;
    for (int c = blockIdx.x * cper; c < min(1024, ((int)blockIdx.x + 1) * cper); ++c) {
        __syncthreads();
        float pv = kpart[(tid >> 1) * 2048 + (tid & 1) * 1024 + c] + kpart[((tid >> 1) + 256) * 2048 + (tid & 1) * 1024 + c];
        pv = wave_sum(pv);
        if (lane == 0) red[w] = pv;
        const bf16* kr = kern2 + (size_t)c * 16384;
#pragma unroll
        for (int k = 0; k < 4; ++k) { const int pc = tid + 512 * k;
            const u32x4 a = *(const u32x4*)(kr + 8 * pc);
            const unsigned v[8] = {a.x & 0xffffu, a.x >> 16, a.y & 0xffffu, a.y >> 16, a.z & 0xffffu, a.z >> 16, a.w & 0xffffu, a.w >> 16};
#pragma unroll
            for (int e = 0; e < 8; ++e) { const int i2 = 8 * pc + e; const int n = i2 < 8192 ? i2 : ((16384 - (i2 - 8192)) & 16383);
                const bool skip0 = (i2 == 8192);
                const int nn = skip0 ? 8192 : n;
                *(LAS bf16*)(lds + FFT_XS + xs_off(nn & 127, nn >> 7)) = skip0 ? (bf16)0 : (bf16)v[e]; } }
        __syncthreads();
        float tot = 0.f;
#pragma unroll
        for (int ww = 0; ww < 8; ++ww) tot += red[ww];
        const float inv = 1.0f / (tot + EPSF);
        const float skip = p.in[I_HBIAS][c];
        frag_t Yb_re[4], Yb_im[4];
        { float cc[4], ss[4];
#pragma unroll
          for (int r = 0; r < 4; ++r) { cc[r] = cb[r]; ss[r] = sb[r]; }
          unsigned lre0 = 0, lre1 = 0, lim0 = 0, lim1 = 0;
#pragma unroll
          for (int rt = 0; rt < 8; ++rt) {
              unsigned xr = (unsigned)((rt & 7) << 5); asm volatile("" : "+s"(xr));
              f32x4 Yre = (f32x4){0.f, 0.f, 0.f, 0.f}, Yim = (f32x4){0.f, 0.f, 0.f, 0.f};
#pragma unroll
              for (int ks_ = 0; ks_ < 4; ++ks_) { const frag_t A = *(const LAS frag_t*)(lds + FFT_XS + rt * 4096 + (fo[ks_] ^ xr));
                  Yre = MFMA16(A, Bre[ks_], Yre); Yim = MFMA16(A, Bim[ks_], Yim); }
              float pr[4], pi[4];
#pragma unroll
              for (int r = 0; r < 4; ++r) { pr[r] = Yre[r] * cc[r] + Yim[r] * ss[r]; pi[r] = Yim[r] * cc[r] - Yre[r] * ss[r];
                  const float cn = cc[r] * cd - ss[r] * sd, sn = ss[r] * cd + cc[r] * sd; cc[r] = cn; ss[r] = sn; }
              if ((rt & 1) == 0) { lre0 = pk2(pr[0], pr[1]); lre1 = pk2(pr[2], pr[3]); lim0 = pk2(pi[0], pi[1]); lim1 = pk2(pi[2], pi[3]); }
              else { Yb_re[rt >> 1] = (frag_t){lre0, lre1, pk2(pr[0], pr[1]), pk2(pr[2], pr[3])}; Yb_im[rt >> 1] = (frag_t){lim0, lim1, pk2(pi[0], pi[1]), pk2(pi[2], pi[3])}; }
          } }
        float* hc = hbuf + (size_t)c * 32768 + (size_t)w * 4096;
#pragma unroll
        for (int rt = 0; rt < 8; ++rt) {
            unsigned xr = (unsigned)((rt & 7) << 5); asm volatile("" : "+s"(xr));
            f32x4 Xre = (f32x4){0.f, 0.f, 0.f, 0.f}, Xim = (f32x4){0.f, 0.f, 0.f, 0.f};
#pragma unroll
            for (int ks_ = 0; ks_ < 4; ++ks_) { const frag_t Ar = *(const LAS frag_t*)(lds + FFT_FP_RE + rt * 4096 + (fo[ks_] ^ xr)), Ai = *(const LAS frag_t*)(lds + FFT_FP_IM + rt * 4096 + (fo[ks_] ^ xr));
                Xre = MFMA16(Ar, Yb_re[ks_], Xre); Xre = MFMA16(Ai, fneg(Yb_im[ks_]), Xre); Xim = MFMA16(Ar, Yb_im[ks_], Xim); Xim = MFMA16(Ai, Yb_re[ks_], Xim); }
            const float sc = inv * (1.0f / 16384.0f), sk = skip * (1.0f / 16384.0f);
            *(f32x4*)(hc + (rt * 2 + 0) * 256 + lane * 4) = Xre * sc + sk;
            *(f32x4*)(hc + (rt * 2 + 1) * 256 + lane * 4) = Xim * sc;
        }
    }
    __syncthreads();
}
struct RawPiece { u32x4 x1d, vd; unsigned x1e, ve; };
__device__ __forceinline__ void conv_taps8(const u32x4 d, unsigned ed, float w0, float w1, float w2, float bias, float (&o)[8]) {
    float e[10];
    e[0] = bf_lo(ed); e[9] = bf_hi(ed);
    e[1] = bf_lo(d.x); e[2] = bf_hi(d.x); e[3] = bf_lo(d.y); e[4] = bf_hi(d.y); e[5] = bf_lo(d.z); e[6] = bf_hi(d.z); e[7] = bf_lo(d.w); e[8] = bf_hi(d.w);
#pragma unroll
    for (int a = 0; a < 8; ++a) o[a] = (w0 * e[a] + w1 * e[a + 1]) + (w2 * e[a + 2] + bias);
}
__device__ __forceinline__ void ph3b_hyena_fftconv(const int wv, const Params& p, unsigned char* smem) {
    const int tid = opaque_tid(wv), lane = tid & 63, w = __builtin_amdgcn_readfirstlane(tid >> 6), r16 = lane & 15, q = lane >> 4;
    LAS unsigned char* lds = (LAS unsigned char*)smem;
    unsigned char* ws = p.ws;
    const bf16* zT = (const bf16*)(ws + WS_ZT);
    bf16* yhT = (bf16*)(ws + WS_YHT);
    const float* hbuf = (const float*)(ws + WS_HBUF);
    const float* cw = p.in[I_HCW]; const float* cbias = p.in[I_HCB];
    __syncthreads();
    fft_load_tables(p, lds, tid);
    const int k1 = 16 * w + r16;
    frag_t Bre[2], Bim[2];
    { const bf16* fn = (const bf16*)(ws + WS_FNAT);
#pragma unroll
      for (int ks_ = 0; ks_ < 2; ++ks_) { Bre[ks_] = *(const frag_t*)(fn + k1 * 128 + 32 * ks_ + 8 * q); Bim[ks_] = *(const frag_t*)(fn + 16384 + k1 * 128 + 32 * ks_ + 8 * q); } }
    float cb[4], sb[4], cd, sd;
#pragma unroll
    for (int r = 0; r < 4; ++r) sincos_f(3.8349519697141029e-4f * (float)(k1 * (4 * q + r)), sb[r], cb[r]);
    sincos_f(3.8349519697141029e-4f * (float)(k1 * 16), sd, cd);
    const int vpos = 32 * (w >> 1) + 8 * (r16 >> 2) + 4 * (w & 1) + (r16 & 3);
    unsigned fo[4], foi[2];
#pragma unroll
    for (int ks_ = 0; ks_ < 4; ++ks_) fo[ks_] = (unsigned)(r16 * 256 + ((((4 * ks_ + q) ^ ((r16 ^ (r16 >> 3)) & 15))) << 4));
#pragma unroll
    for (int ks_ = 0; ks_ < 2; ++ks_) foi[ks_] = (unsigned)(r16 * 256 + ((((8 + 4 * ks_ + q) ^ ((r16 ^ (r16 >> 3)) & 15))) << 4));
    const int nseq = 4096, per = __builtin_amdgcn_readfirstlane((int)((nseq + gridDim.x - 1) / gridDim.x));
    const int sq0 = __builtin_amdgcn_readfirstlane((int)(blockIdx.x * per)), sq1 = __builtin_amdgcn_readfirstlane(min(nseq, sq0 + per));
#define FFT_RAW_LOAD(sq_) do { const int c_ = (sq_) >> 2, bp_ = (sq_) & 3; \
        const bf16* x1u = zT + ((size_t)((1 * NB + 2 * bp_) * 1024 + c_)) * SEQ; const bf16* vu = zT + ((size_t)((2 * NB + 2 * bp_) * 1024 + c_)) * SEQ;     \
        int tl_ = tid; asm volatile("" : "+v"(tl_)); \
        _Pragma("unroll") for (int k = 0; k < 4; ++k) { const int pc = tl_ + 512 * k, sel = pc >> 10, idx = pc & 1023; const unsigned po = (unsigned)(sel * 1024 * SEQ + 8 * idx); \
            raw[k].x1d = *(const u32x4*)(x1u + po); raw[k].vd = *(const u32x4*)(vu + po); \
            const unsigned pm = idx > 0 ? po - 1u : po, pp = idx < 1023 ? po + 8u : po; \
            const unsigned xa = idx > 0 ? (unsigned)x1u[pm] : 0u, xb = idx < 1023 ? (unsigned)x1u[pp] : 0u, va = idx > 0 ? (unsigned)vu[pm] : 0u, vb = idx < 1023 ? (unsigned)vu[pp] : 0u; \
            raw[k].x1e = xa | (xb << 16); raw[k].ve = va | (vb << 16); } } while (0)
#define FFT_RAW_STAGE(sq_) do { const int c_ = (sq_) >> 2; \
        const float x1w0 = cw[1024 + c_], x1w1 = cw[3072 + 1024 + c_], x1w2 = cw[6144 + 1024 + c_], x1b = cbias[1024 + c_]; \
        const float vw0 = cw[2048 + c_], vw1 = cw[3072 + 2048 + c_], vw2 = cw[6144 + 2048 + c_], vb_ = cbias[2048 + c_]; \
        int tt_ = tid; asm volatile("" : "+v"(tt_)); \
        _Pragma("unroll") for (int k = 0; k < 4; ++k) { const int pc = tt_ + 512 * k, sel = pc >> 10, idx = pc & 1023; const int n1 = idx >> 4, n20 = (idx & 15) * 8; \
            float a1[8], a2[8]; conv_taps8(raw[k].x1d, raw[k].x1e, x1w0, x1w1, x1w2, x1b, a1); conv_taps8(raw[k].vd, raw[k].ve, vw0, vw1, vw2, vb_, a2); \
            _Pragma("unroll") for (int e = 0; e < 8; ++e) *(LAS bf16*)(lds + FFT_XS + xs_off(n20 + e, n1 + 64 * sel)) = (bf16)f2bf(a1[e] * a2[e]); } } while (0)
    if (sq0 < sq1) { RawPiece raw[4]; FFT_RAW_LOAD(sq0); FFT_RAW_STAGE(sq0); }
    __syncthreads();
    for (int sq = sq0; sq < sq1; ++sq) {
        const int sqn = min(sq + 1, sq1 - 1);
        RawPiece raw[4]; FFT_RAW_LOAD(sqn);
        SEC_BEGIN(2);
        frag_t Yb_re[4], Yb_im[4];
        { float cc[4], ss[4];
#pragma unroll
          for (int r = 0; r < 4; ++r) { cc[r] = cb[r]; ss[r] = sb[r]; }
          unsigned lre0 = 0, lre1 = 0, lim0 = 0, lim1 = 0;
#pragma unroll
          for (int rt = 0; rt < 8; ++rt) {
              unsigned xr = (unsigned)((rt & 7) << 5); asm volatile("" : "+s"(xr));
              f32x4 Yre = (f32x4){0.f, 0.f, 0.f, 0.f}, Yim = (f32x4){0.f, 0.f, 0.f, 0.f};
#pragma unroll
              for (int ks_ = 0; ks_ < 2; ++ks_) { const frag_t Ar = *(const LAS frag_t*)(lds + FFT_XS + rt * 4096 + (fo[ks_] ^ xr)), Ai = *(const LAS frag_t*)(lds + FFT_XS + rt * 4096 + (foi[ks_] ^ xr));
                  Yre = MFMA16(Ar, Bre[ks_], Yre); Yre = MFMA16(Ai, fneg(Bim[ks_]), Yre); Yim = MFMA16(Ar, Bim[ks_], Yim); Yim = MFMA16(Ai, Bre[ks_], Yim); }
              float pr[4], pi[4];
#pragma unroll
              for (int r = 0; r < 4; ++r) { pr[r] = Yre[r] * cc[r] + Yim[r] * ss[r]; pi[r] = Yim[r] * cc[r] - Yre[r] * ss[r];
                  const float cn = cc[r] * cd - ss[r] * sd, sn = ss[r] * cd + cc[r] * sd; cc[r] = cn; ss[r] = sn; }
              if ((rt & 1) == 0) { lre0 = pk2(pr[0], pr[1]); lre1 = pk2(pr[2], pr[3]); lim0 = pk2(pi[0], pi[1]); lim1 = pk2(pi[2], pi[3]); }
              else { Yb_re[rt >> 1] = (frag_t){lre0, lre1, pk2(pr[0], pr[1]), pk2(pr[2], pr[3])}; Yb_im[rt >> 1] = (frag_t){lim0, lim1, pk2(pi[0], pi[1]), pk2(pi[2], pi[3])}; }
          } }
        SEC_END(2, ws); SEC_BEGIN(3); SEC_BEGIN(8);
        __syncthreads();
        FFT_RAW_STAGE(sqn);
        SEC_END(8, ws); SEC_BEGIN(9);
        frag_t Zb_re[4], Zb_im[4];
        { int sqc = sq; asm volatile("" : "+s"(sqc));
          const float* hc = hbuf + (size_t)(sqc >> 2) * 32768 + (size_t)w * 4096;
          unsigned lre0 = 0, lre1 = 0, lim0 = 0, lim1 = 0;
          f32x4 Hrn = *(const f32x4*)(hc + lane * 4), Hin = *(const f32x4*)(hc + 256 + lane * 4);
#pragma unroll
          for (int rt = 0; rt < 8; ++rt) {
              unsigned xr = (unsigned)((rt & 7) << 5); asm volatile("" : "+s"(xr));
              const f32x4 Hr = Hrn, Hi = Hin;
              if (rt < 7) { Hrn = *(const f32x4*)(hc + ((rt + 1) * 2 + 0) * 256 + lane * 4); Hin = *(const f32x4*)(hc + ((rt + 1) * 2 + 1) * 256 + lane * 4); }
              f32x4 Xre = (f32x4){0.f, 0.f, 0.f, 0.f}, Xim = (f32x4){0.f, 0.f, 0.f, 0.f};
#pragma unroll
              for (int ks_ = 0; ks_ < 4; ++ks_) { const frag_t Ar = *(const LAS frag_t*)(lds + FFT_FP_RE + rt * 4096 + (fo[ks_] ^ xr)), Ai = *(const LAS frag_t*)(lds + FFT_FP_IM + rt * 4096 + (fo[ks_] ^ xr));
                  Xre = MFMA16(Ar, Yb_re[ks_], Xre); Xre = MFMA16(Ai, fneg(Yb_im[ks_]), Xre); Xim = MFMA16(Ar, Yb_im[ks_], Xim); Xim = MFMA16(Ai, Yb_re[ks_], Xim); }
              const f32x4 zr = Xre * Hr - Xim * Hi, zi = Xre * Hi + Xim * Hr;
              if ((rt & 1) == 0) { lre0 = pk2(zr[0], zr[1]); lre1 = pk2(zr[2], zr[3]); lim0 = pk2(zi[0], zi[1]); lim1 = pk2(zi[2], zi[3]); }
              else { Zb_re[rt >> 1] = (frag_t){lre0, lre1, pk2(zr[0], zr[1]), pk2(zr[2], zr[3])}; Zb_im[rt >> 1] = (frag_t){lim0, lim1, pk2(zi[0], zi[1]), pk2(zi[2], zi[3])}; }
          } }
        SEC_END(9, ws); SEC_BEGIN(10);
        { float cc[4], ss[4];
#pragma unroll
          for (int r = 0; r < 4; ++r) { cc[r] = cb[r]; ss[r] = sb[r]; }
          unsigned vo[4];
          { int q4 = 4 * q; asm volatile("" : "+v"(q4));
#pragma unroll
            for (int r = 0; r < 4; ++r) { const int x_ = q4 + r; vo[r] = (unsigned)(x_ * 256 + ((((vpos >> 3) ^ ((x_ ^ (x_ >> 3)) & 15))) << 4) + ((vpos & 7) << 1)); } }
#pragma unroll
          for (int rt = 0; rt < 8; ++rt) {
              unsigned xr = (unsigned)((rt & 7) << 5); asm volatile("" : "+s"(xr));
              f32x4 Vre = (f32x4){0.f, 0.f, 0.f, 0.f}, Vim = (f32x4){0.f, 0.f, 0.f, 0.f};
#pragma unroll
              for (int ks_ = 0; ks_ < 4; ++ks_) { const frag_t Ar = *(const LAS frag_t*)(lds + FFT_FP_RE + rt * 4096 + (fo[ks_] ^ xr)), Ai = *(const LAS frag_t*)(lds + FFT_FP_IM + rt * 4096 + (fo[ks_] ^ xr));
                  Vre = MFMA16(Ar, Zb_re[ks_], Vre); Vre = MFMA16(Ai, Zb_im[ks_], Vre); Vim = MFMA16(Ar, Zb_im[ks_], Vim); Vim = MFMA16(Ai, fneg(Zb_re[ks_]), Vim); }
#pragma unroll
              for (int r = 0; r < 4; ++r) { const float pr = Vre[r] * cc[r] - Vim[r] * ss[r], pi = Vim[r] * cc[r] + Vre[r] * ss[r];
                  const float cn = cc[r] * cd - ss[r] * sd, sn = ss[r] * cd + cc[r] * sd; cc[r] = cn; ss[r] = sn;
                  const unsigned off = rt * 4096 + (vo[r] ^ xr);
                  *(LAS bf16*)(lds + FFT_VB_RE + off) = (bf16)f2bf(pr); *(LAS bf16*)(lds + FFT_VB_IM + off) = (bf16)f2bf(pi); }
          } }
        __syncthreads();
        SEC_END(3, ws); SEC_END(10, ws); SEC_BEGIN(4);
        { frag_t Vr[4], Vi[4];
#pragma unroll
          for (int ks_ = 0; ks_ < 4; ++ks_) { Vr[ks_] = *(const LAS frag_t*)(lds + FFT_VB_RE + w * 4096 + (fo[ks_] ^ ((w & 7) << 5))); Vi[ks_] = *(const LAS frag_t*)(lds + FFT_VB_IM + w * 4096 + (fo[ks_] ^ ((w & 7) << 5))); }
          int sqe = sq; asm volatile("" : "+s"(sqe));
          const int c = sqe >> 2, bp = sqe & 3;
          u32x4 x0d[4]; unsigned x0e[4];
          { const bf16* x0u = zT + ((size_t)((0 * NB + 2 * bp) * 1024 + c)) * SEQ;
            int tl_ = tid; asm volatile("" : "+v"(tl_));
#pragma unroll
            for (int k = 0; k < 4; ++k) { const int pc = tl_ + 512 * k, sel = pc >> 10, idx = pc & 1023; const unsigned po = (unsigned)(sel * 1024 * SEQ + 8 * idx);
                x0d[k] = *(const u32x4*)(x0u + po);
                const unsigned pm = idx > 0 ? po - 1u : po, pp = idx < 1023 ? po + 8u : po;
                const unsigned xa = idx > 0 ? (unsigned)x0u[pm] : 0u, xb = idx < 1023 ? (unsigned)x0u[pp] : 0u;
                x0e[k] = xa | (xb << 16); } }
          asm volatile("s_waitcnt lgkmcnt(0)" ::: "memory");
          __syncthreads();
          int tbase = 512 * q + 16 * w + r16; asm volatile("" : "+v"(tbase));
#pragma unroll
          for (int rt = 0; rt < 4; ++rt) {
              unsigned xr = (unsigned)((rt & 7) << 5); asm volatile("" : "+s"(xr));
              f32x4 yre = (f32x4){0.f, 0.f, 0.f, 0.f}, yim = (f32x4){0.f, 0.f, 0.f, 0.f};
#pragma unroll
              for (int ks_ = 0; ks_ < 4; ++ks_) { const frag_t Ar = *(const LAS frag_t*)(lds + FFT_FP_RE + rt * 4096 + (fo[ks_] ^ xr)), Ai = *(const LAS frag_t*)(lds + FFT_FP_IM + rt * 4096 + (fo[ks_] ^ xr));
                  yre = MFMA16(Ar, Vr[ks_], yre); yre = MFMA16(Ai, Vi[ks_], yre); yim = MFMA16(Ar, Vi[ks_], yim); yim = MFMA16(Ai, fneg(Vr[ks_]), yim); }
#pragma unroll
              for (int r = 0; r < 4; ++r) { const int t = tbase + 128 * (16 * rt + r);
                  *(LAS bf16*)(lds + FFT_VB_RE + 2 * t) = (bf16)f2bf(yre[r]); *(LAS bf16*)(lds + FFT_VB_RE + 16384 + 2 * t) = (bf16)f2bf(yim[r]); }
          }
          asm volatile("s_waitcnt lgkmcnt(0)" ::: "memory");
          __syncthreads();
          const float x0w0 = cw[c], x0w1 = cw[3072 + c], x0w2 = cw[6144 + c], x0b = cbias[c];
          bf16* ou = yhT + ((size_t)((2 * bp) * 1024 + c)) * SEQ;
          { int tl_ = tid; asm volatile("" : "+v"(tl_));
#pragma unroll
            for (int k = 0; k < 4; ++k) { const int pc = tl_ + 512 * k, sel = pc >> 10, idx = pc & 1023; const unsigned po = (unsigned)(sel * 1024 * SEQ + 8 * idx);
                float xc[8]; conv_taps8(x0d[k], x0e[k], x0w0, x0w1, x0w2, x0b, xc);
                const u32x4 yv = *(const LAS u32x4*)(lds + FFT_VB_RE + sel * 16384 + 16 * idx);
                float yy[8]; unpack8(yv, yy);
                u32x4 o; o.x = pk2(yy[0] * xc[0], yy[1] * xc[1]); o.y = pk2(yy[2] * xc[2], yy[3] * xc[3]); o.z = pk2(yy[4] * xc[4], yy[5] * xc[5]); o.w = pk2(yy[6] * xc[6], yy[7] * xc[7]);
                *(u32x4*)(ou + po) = o; } }
        }
        SEC_END(4, ws);
    }
#undef FFT_RAW_LOAD
#undef FFT_RAW_STAGE
    __syncthreads();
}

__device__ __forceinline__ bf16x8 mk8(unsigned a, unsigned b, unsigned c, unsigned d) { u32x4 t = {a, b, c, d}; return __builtin_bit_cast(bf16x8, t); }
#ifndef RET_SBM
#define RET_SBM 0
#endif
#define RET_SB1 do { if (RET_SBM & 1) __builtin_amdgcn_sched_barrier(0); } while (0)
#define RET_SB2 do { if (RET_SBM & 2) __builtin_amdgcn_sched_barrier(0); } while (0)
#define RET_SB3 do { if (RET_SBM & 4) __builtin_amdgcn_sched_barrier(0); } while (0)
__device__ __forceinline__ void ph4_retention(const int wv, const Params& p, unsigned char* smem) {
    constexpr int PK = 136;
#define KT_OFF(d_, j_) ((d_) * PK + (((((j_) >> 3) ^ (((d_) >> 3) & 15)) << 3) | ((j_) & 7)))
#define VT_OFF(v_, j_) ((v_) * PK + (((((j_) >> 3) ^ (((v_) >> 3) & 7)) << 3) | ((j_) & 7)))
    const int tid = opaque_tid(wv), lane = tid & 63, w = __builtin_amdgcn_readfirstlane(tid >> 6), r16 = lane & 15, q = lane >> 4;
    unsigned char* ws = p.ws;
    LAS unsigned char* lds = (LAS unsigned char*)smem;
    LAS bf16* Ks = (LAS bf16*)lds;
    LAS bf16* KTs = (LAS bf16*)(lds + 34816);
    LAS bf16* VTs = (LAS bf16*)(lds + 69632);
    LAS bf16* STs = (LAS bf16*)(lds + 87040);
    const bf16* QKb = (const bf16*)(ws + WS_QK); const bf16* Vb = (const bf16*)(ws + WS_V);
    const bf16* CKb = (const bf16*)(ws + WS_CK); const bf16* CVb = (const bf16*)(ws + WS_CV);
    for (int un0 = blockIdx.x; un0 < 256; un0 += gridDim.x) {
        const int un = (gridDim.x == 256) ? ((((un0 & 7) * 4 + (un0 >> 6)) << 3) | ((un0 >> 3) & 7)) : un0;
        const int b = un >> 5, h = (un >> 3) & 3, dir = (un >> 2) & 1, vs = un & 3;
        const float lg2 = (dir ? p.in[I_LGB] : p.in[I_LGF])[h] * 1.4426950408889634f;
        const float gC = exp2f(lg2 * 128.0f);
        bf16* Odst = (bf16*)(ws + (dir ? WS_OB : WS_OF));
        const int kj_ = tid >> 4, kcq = tid & 15;
        const int vj_ = tid >> 3, vcq = tid & 7;
        const int kj = kj_, vj = vj_;
        float zeta[4];
#pragma unroll
        for (int k = 0; k < 4; ++k) { const int j = kj + 32 * k; zeta[k] = exp2f(lg2 * (float)(dir ? j : 127 - j)); }
        float xil;
        { const int i = 16 * w + r16; xil = exp2f(lg2 * (float)((dir ? 127 - i : i) + 1)); }
        const float sgf = dir ? -1.0f : 1.0f;
        int tr[4]; float pr[4];
        { int il = 16 * w + r16; asm volatile("" : "+v"(il));
#pragma unroll
          for (int r = 0; r < 4; ++r) { tr[r] = il - 4 * q - r; pr[r] = exp2f(lg2 * sgf * (float)tr[r]); } }
        float scs[8];
#pragma unroll
        for (int e = 0; e < 8; ++e) scs[e] = __int_as_float(__builtin_amdgcn_readfirstlane(__float_as_int(exp2f(-lg2 * sgf * (float)(16 * e)))));
        f32x4 Sacc[4];
#pragma unroll
        for (int vt = 0; vt < 4; ++vt) Sacc[vt] = (f32x4){0.f, 0.f, 0.f, 0.f};
        u32x4 kreg[4], vreg[2]; bf16x8 qf[4];
#pragma unroll
        for (int k = 0; k < 4; ++k) qf[k] = mk8(0, 0, 0, 0);
#define RET_LOAD(st_) do { const int s_ = (st_); int kj = kj_; asm volatile("" : "+v"(kj)); int vj = vj_; asm volatile("" : "+v"(vj));        \
            if (s_ < 2) { const int ci = dir ? 1 - s_ : s_; const size_t tok0 = (size_t)b * 256 + ci * 128; \
                const bf16* Kp = CKb + tok0 * 512 + h * 128; const bf16* Vp = CVb + tok0 * 1024 + h * 256 + vs * 64; \
                _Pragma("unroll") for (int k = 0; k < 4; ++k) kreg[k] = *(const u32x4*)(Kp + (size_t)(kj + 32 * k) * 512 + 8 * kcq); \
                _Pragma("unroll") for (int k = 0; k < 2; ++k) vreg[k] = *(const u32x4*)(Vp + (size_t)(vj + 64 * k) * 1024 + 8 * vcq); \
            } else { const int n = dir ? 63 - (s_ - 2) : s_ - 2; const size_t tok0 = (size_t)b * SEQ + n * 128; \
                const bf16* Kp = QKb + tok0 * 1024 + 512 + h * 128; const bf16* Vp = Vb + tok0 * 1024 + h * 256 + vs * 64; \
                _Pragma("unroll") for (int k = 0; k < 4; ++k) kreg[k] = *(const u32x4*)(Kp + (size_t)(kj + 32 * k) * 1024 + 8 * kcq); \
                _Pragma("unroll") for (int k = 0; k < 2; ++k) vreg[k] = *(const u32x4*)(Vp + (size_t)(vj + 64 * k) * 1024 + 8 * vcq); \
            } } while (0)
        RET_LOAD(0);
        for (int st = 0; st < 66; ++st) {
            if (st >= 2) { const int n = dir ? 63 - (st - 2) : st - 2; const bf16* Qp = QKb + ((size_t)b * SEQ + n * 128) * 1024 + h * 128;
                { int qro = (16 * w + r16) * 1024 + 8 * q; asm volatile("" : "+v"(qro));
#pragma unroll
                  for (int k = 0; k < 4; ++k) qf[k] = *(const bf16x8*)(Qp + qro + 32 * k); } }
            SEC_BEGIN(5); SEC_BEGIN(12);
            __syncthreads();
            SEC_END(12, ws); SEC_BEGIN(13);
#pragma unroll
            for (int k = 0; k < 4; ++k) { const int j = kj + 32 * k; *(LAS u32x4*)(Ks + j * PK + 8 * kcq) = kreg[k];
                const unsigned wv[4] = {kreg[k].x, kreg[k].y, kreg[k].z, kreg[k].w};
#pragma unroll
                for (int e2 = 0; e2 < 4; ++e2) { KTs[KT_OFF(8 * kcq + 2 * e2, j)] = (bf16)f2bf(bf_lo(wv[e2]) * zeta[k]); KTs[KT_OFF(8 * kcq + 2 * e2 + 1, j)] = (bf16)f2bf(bf_hi(wv[e2]) * zeta[k]); } }
#pragma unroll
            for (int k = 0; k < 2; ++k) { const int j = vj + 64 * k; const unsigned wv[4] = {vreg[k].x, vreg[k].y, vreg[k].z, vreg[k].w};
#pragma unroll
                for (int e2 = 0; e2 < 4; ++e2) { VTs[VT_OFF(8 * vcq + 2 * e2, j)] = (bf16)(wv[e2] & 0xffffu); VTs[VT_OFF(8 * vcq + 2 * e2 + 1, j)] = (bf16)(wv[e2] >> 16); } }
#pragma unroll
            for (int vt = 0; vt < 4; ++vt) { u32x2 sv; sv.x = pk2(Sacc[vt][0], Sacc[vt][1]); sv.y = pk2(Sacc[vt][2], Sacc[vt][3]); *(LAS u32x2*)(STs + (16 * vt + r16) * PK + 16 * w + 4 * q) = sv; }
            asm volatile("s_waitcnt lgkmcnt(0)" ::: "memory"); SEC_END(13, ws); SEC_BEGIN(14);
            __syncthreads();
            SEC_END(14, ws); SEC_END(5, ws); SEC_BEGIN(6);
            if (st + 1 < 66) RET_LOAD(st + 1);
            int r16s = r16; asm volatile("" : "+v"(r16s));
            if (st >= 2) {
                const int n = dir ? 63 - (st - 2) : st - 2; const size_t tok0 = (size_t)b * SEQ + n * 128;
                bf16x8 Pf[4];
                bf16x8 Ak[2][8];
#pragma unroll
                for (int kd = 0; kd < 4; ++kd) { Ak[0][2 * kd] = *(const LAS bf16x8*)(Ks + r16 * PK + 32 * kd + 8 * q); Ak[0][2 * kd + 1] = *(const LAS bf16x8*)(Ks + (16 + r16) * PK + 32 * kd + 8 * q); }
#pragma unroll
                for (int ks_ = 0; ks_ < 4; ++ks_) {
                    f32x4 Xa = (f32x4){0.f, 0.f, 0.f, 0.f}, Xb = (f32x4){0.f, 0.f, 0.f, 0.f};
                    if (ks_ < 3) {
#pragma unroll
                        for (int kd = 0; kd < 4; ++kd) { Ak[(ks_ + 1) & 1][2 * kd] = *(const LAS bf16x8*)(Ks + (32 * (ks_ + 1) + r16) * PK + 32 * kd + 8 * q); Ak[(ks_ + 1) & 1][2 * kd + 1] = *(const LAS bf16x8*)(Ks + (32 * (ks_ + 1) + 16 + r16) * PK + 32 * kd + 8 * q); } }
                    __builtin_amdgcn_sched_barrier(0);
#pragma unroll
                    for (int kd = 0; kd < 4; ++kd) { Xa = __builtin_amdgcn_mfma_f32_16x16x32_bf16(Ak[ks_ & 1][2 * kd], qf[kd], Xa, 0, 0, 0); Xb = __builtin_amdgcn_mfma_f32_16x16x32_bf16(Ak[ks_ & 1][2 * kd + 1], qf[kd], Xb, 0, 0, 0); }
                    float pv[8];
#pragma unroll
                    for (int r = 0; r < 4; ++r) { const int da = tr[r] - 32 * ks_, db = da - 16; const bool oka = dir ? (da <= 0) : (da >= 0), okb = dir ? (db <= 0) : (db >= 0);
                        pv[r] = oka ? Xa[r] * (pr[r] * scs[2 * ks_]) : 0.f; pv[4 + r] = okb ? Xb[r] * (pr[r] * scs[2 * ks_ + 1]) : 0.f; }
                    Pf[ks_] = mk8(pk2(pv[0], pv[1]), pk2(pv[2], pv[3]), pk2(pv[4], pv[5]), pk2(pv[6], pv[7]));
                    RET_SB1;
                }
                bf16x8 Sq[2][4], Vq[2][4];
#define RET_LDO(buf_, vt_) do { _Pragma("unroll") for (int ks_ = 0; ks_ < 4; ++ks_) { Sq[buf_][ks_] = *(const LAS bf16x8*)(STs + (16 * (vt_) + r16) * PK + 32 * ks_ + 8 * q); \
                    const u32x2 lo = *(const LAS u32x2*)(VTs + VT_OFF(16 * (vt_) + r16s, 32 * ks_ + 4 * q)), hi = *(const LAS u32x2*)(VTs + VT_OFF(16 * (vt_) + r16s, 32 * ks_ + 16 + 4 * q)); \
                    Vq[buf_][ks_] = mk8(lo.x, lo.y, hi.x, hi.y); } } while (0)
                RET_LDO(0, 0);
#pragma unroll
                for (int vt = 0; vt < 4; ++vt) { f32x4 O = (f32x4){0.f, 0.f, 0.f, 0.f};
                    if (vt < 3) RET_LDO((vt + 1) & 1, vt + 1);
                    __builtin_amdgcn_sched_barrier(0);
#pragma unroll
                    for (int ks_ = 0; ks_ < 4; ++ks_) O = __builtin_amdgcn_mfma_f32_16x16x32_bf16(Sq[vt & 1][ks_], qf[ks_], O, 0, 0, 0);
#pragma unroll
                    for (int r = 0; r < 4; ++r) O[r] *= xil;
#pragma unroll
                    for (int ks_ = 0; ks_ < 4; ++ks_) O = __builtin_amdgcn_mfma_f32_16x16x32_bf16(Vq[vt & 1][ks_], Pf[ks_], O, 0, 0, 0);
                    bf16* od = Odst + (tok0 + 16 * w + r16s) * 1024 + h * 256 + vs * 64 + 16 * vt + 4 * q;
                    u32x2 ov; ov.x = pk2(O[0], O[1]); ov.y = pk2(O[2], O[3]);
                    *(u32x2*)od = ov;
                    RET_SB2;
                }
#undef RET_LDO
            }
            { bf16x8 Ka[4], Vb[2][4];
#pragma unroll
              for (int ks_ = 0; ks_ < 4; ++ks_) { Ka[ks_] = *(const LAS bf16x8*)(KTs + KT_OFF(16 * w + r16s, 32 * ks_ + 8 * q)); Vb[0][ks_] = *(const LAS bf16x8*)(VTs + VT_OFF(r16s, 32 * ks_ + 8 * q)); }
#pragma unroll
              for (int vt = 0; vt < 4; ++vt) { Sacc[vt] = Sacc[vt] * gC;
                if (vt < 3) {
#pragma unroll
                    for (int ks_ = 0; ks_ < 4; ++ks_) Vb[(vt + 1) & 1][ks_] = *(const LAS bf16x8*)(VTs + VT_OFF(16 * (vt + 1) + r16s, 32 * ks_ + 8 * q)); }
                __builtin_amdgcn_sched_barrier(0);
#pragma unroll
                for (int ks_ = 0; ks_ < 4; ++ks_) Sacc[vt] = __builtin_amdgcn_mfma_f32_16x16x32_bf16(Ka[ks_], Vb[vt & 1][ks_], Sacc[vt], 0, 0, 0);
                RET_SB3; } }
            SEC_END(6, ws);
        }
#undef RET_LOAD
#undef KT_OFF
#undef VT_OFF
    }
    __syncthreads();
}
__device__ __forceinline__ void ph4_transpose_yh(const int wv, const Params& p, unsigned char* smem) {
    const int tid = opaque_tid(wv), lane = tid & 63, wave = __builtin_amdgcn_readfirstlane(tid >> 6);
    const int gw = blockIdx.x * 8 + wave, NGW = gridDim.x * 8;
    LAS bf16* tile = (LAS bf16*)((LAS unsigned char*)smem + wave * 8448);
    const bf16* yhT = (const bf16*)(p.ws + WS_YHT); bf16* yh = (bf16*)(p.ws + WS_YH);
    for (int it = gw; it < 16384; it += NGW) {
        const int b = it >> 11, cb = (it >> 7) & 15, tb = it & 127;
        const bf16* src = yhT + ((size_t)(b * 1024 + cb * 64)) * SEQ + tb * 64;
#pragma unroll
        for (int k = 0; k < 8; ++k) { const int pc = lane + 64 * k, row = pc >> 3, ch = pc & 7; const u32x4 v = *(const u32x4*)(src + (size_t)row * SEQ + 8 * ch);
            const unsigned wv[4] = {v.x, v.y, v.z, v.w};
#pragma unroll
            for (int e2 = 0; e2 < 4; ++e2) { tile[(8 * ch + 2 * e2) * 66 + row] = (bf16)(wv[e2] & 0xffffu); tile[(8 * ch + 2 * e2 + 1) * 66 + row] = (bf16)(wv[e2] >> 16); } }
        __builtin_amdgcn_s_waitcnt(0xC07F); asm volatile("" ::: "memory");
        bf16* dst = yh + ((size_t)(b * SEQ + tb * 64)) * 1024 + cb * 64;
#pragma unroll
        for (int k = 0; k < 32; ++k) { const int idx = lane + 64 * k, trow = idx >> 5, cw = idx & 31; const unsigned wd = *(const LAS unsigned*)(tile + trow * 66 + 2 * cw);
            *(unsigned*)(dst + (size_t)trow * 1024 + 2 * cw) = wd; }
        __builtin_amdgcn_s_waitcnt(0xC07F); asm volatile("" ::: "memory");
    }
}

__device__ __forceinline__ void readout_items(const int wv, const Params& p, const int it0, const int it1, const int first, const int stride) {
    const int lane = opaque_tid(wv) & 63;
    bf16* OF = (bf16*)(p.ws + WS_OF); const bf16* OB = (const bf16*)(p.ws + WS_OB); const bf16* G = (const bf16*)(p.ws + WS_G);
    for (int it = it0 + first; it < it1; it += 4 * stride) {
        u32x2 a[4], b[4], g[4]; size_t off[4];
#pragma unroll
        for (int u = 0; u < 4; ++u) { const int itu = min(it + u * stride, it1 - 1); off[u] = (size_t)itu * 256 + 4 * lane; a[u] = *(const u32x2*)(OF + off[u]); b[u] = *(const u32x2*)(OB + off[u]); g[u] = *(const u32x2*)(G + off[u]); }
#pragma unroll
        for (int u = 0; u < 4; ++u) {
            float o[4] = {bf_lo(a[u].x) + bf_lo(b[u].x), bf_hi(a[u].x) + bf_hi(b[u].x), bf_lo(a[u].y) + bf_lo(b[u].y), bf_hi(a[u].y) + bf_hi(b[u].y)};
            float ss = (o[0] * o[0] + o[1] * o[1]) + (o[2] * o[2] + o[3] * o[3]);
            ss = wave_sum_dpp(ss);
            const float rs = 1.0f / sqrtf(ss * (1.0f / 256.0f) + EPSF);
            u32x2 r; r.x = pk2(o[0] * rs * bf_lo(g[u].x), o[1] * rs * bf_hi(g[u].x)); r.y = pk2(o[2] * rs * bf_lo(g[u].y), o[3] * rs * bf_hi(g[u].y));
            if (it + u * stride < it1) *(u32x2*)(OF + off[u]) = r; }
    }
}
__device__ __forceinline__ void convert_expert_tables(const int wv, const Params& p, const int wg_first, const int wg_count) {
    const int tid = opaque_tid(wv);
    const size_t gt = (size_t)((int)blockIdx.x - wg_first) * NTHR + tid, NGT = (size_t)wg_count * NTHR;
    for (size_t i = gt; i < (size_t)2 * 16384 * 64; i += NGT) {
        const size_t tsel = i >> 20, j = i & ((1u << 20) - 1);
        const float* src = (tsel ? p.in[I_PV] : p.in[I_PU]) + j * 16; const float sc = tsel ? 5.0f : 56.0f;
        u32x2 o;
#pragma unroll
        for (int d = 0; d < 2; ++d) { const f32x4 a = *(const f32x4*)(src + 8 * d) * sc, b2 = *(const f32x4*)(src + 8 * d + 4) * sc;
            unsigned w = 0u;
            w = __builtin_amdgcn_cvt_scalef32_pk_fp4_f32(w, a.x, a.y, 1.0f, 0); w = __builtin_amdgcn_cvt_scalef32_pk_fp4_f32(w, a.z, a.w, 1.0f, 1);
            w = __builtin_amdgcn_cvt_scalef32_pk_fp4_f32(w, b2.x, b2.y, 1.0f, 2); w = __builtin_amdgcn_cvt_scalef32_pk_fp4_f32(w, b2.z, b2.w, 1.0f, 3);
            o[d] = w; }
        *(u32x2*)(p.ws + (tsel ? WS_PV : WS_PU) + j * 8) = o;
    }
}

__device__ __forceinline__ void rows2_range(const int wv, const Params& p, const int r0, const int r1) {
    const int tid = opaque_tid(wv), lane = tid & 63, wave = __builtin_amdgcn_readfirstlane(tid >> 6);
    const float* mod = (const float*)(p.ws + WS_MOD);
    const float* md = mod + (r0 >> 13) * 6144;
    f32x4 gsc[4], shv[4];
#pragma unroll
    for (int j = 0; j < 4; ++j) { const int c0 = 4 * lane + 256 * j; gsc[j] = *(const f32x4*)(p.in[I_NORM2] + c0) * (*(const f32x4*)(md + 4096 + c0) + 1.0f); shv[j] = *(const f32x4*)(md + 3072 + c0); }
    const bf16* Yb = (const bf16*)(p.ws + WS_V);
    f32x4 vn[4], vm[4]; u32x2 yn[4], ym[4];
#pragma unroll
    for (int j = 0; j < 4; ++j) { vn[j] = *(const f32x4*)(p.in[I_X] + (size_t)(r0 + wave) * 1024 + 4 * lane + 256 * j); yn[j] = *(const u32x2*)(Yb + (size_t)(r0 + wave) * 1024 + 4 * lane + 256 * j); }
    { const int rq = (r0 + wave + 8 < r1) ? r0 + wave + 8 : r0 + wave;
#pragma unroll
      for (int j = 0; j < 4; ++j) { vm[j] = *(const f32x4*)(p.in[I_X] + (size_t)rq * 1024 + 4 * lane + 256 * j); ym[j] = *(const u32x2*)(Yb + (size_t)rq * 1024 + 4 * lane + 256 * j); } }
    for (int r = r0 + wave; r < r1; r += 8) {
        bf16* dst = (bf16*)(p.ws + WS_H2) + (size_t)r * 1024; unsigned char* dst8 = p.ws + WS_X8 + (size_t)r * 1024;
        f32x4 v[4]; float ss = 0.f;
#pragma unroll
        for (int j = 0; j < 4; ++j) { v[j] = vn[j] + (f32x4){bf_lo(yn[j].x), bf_hi(yn[j].x), bf_lo(yn[j].y), bf_hi(yn[j].y)}; ss += (v[j].x * v[j].x + v[j].y * v[j].y) + (v[j].z * v[j].z + v[j].w * v[j].w); }
        { const int rn = (r + 16 < r1) ? r + 16 : r;
#pragma unroll
          for (int j = 0; j < 4; ++j) { vn[j] = vm[j]; yn[j] = ym[j]; vm[j] = *(const f32x4*)(p.in[I_X] + (size_t)rn * 1024 + 4 * lane + 256 * j); ym[j] = *(const u32x2*)(Yb + (size_t)rn * 1024 + 4 * lane + 256 * j); } }
        ss = wave_sum_dpp(ss);
        const float rs = 1.0f / sqrtf(ss * (1.0f / 1024.0f) + EPSF);
#pragma unroll
        for (int j = 0; j < 4; ++j) { const int c0 = 4 * lane + 256 * j;
            const f32x4 y = v[j] * rs * gsc[j] + shv[j];
            u32x2 o; o.x = pk2(y.x, y.y); o.y = pk2(y.z, y.w);
            *(u32x2*)(dst + c0) = o;
            const float x0 = bf_lo(o.x) * 1.5f, x1 = bf_hi(o.x) * 1.5f, x2 = bf_lo(o.y) * 1.5f, x3 = bf_hi(o.y) * 1.5f;
            unsigned wh = __builtin_amdgcn_cvt_scalef32_pk_fp4_f32(0u, x0, x1, 1.0f, 0); wh = __builtin_amdgcn_cvt_scalef32_pk_fp4_f32(wh, x2, x3, 1.0f, 1);
            const f32x2 d01 = __builtin_amdgcn_cvt_scalef32_pk_f32_fp4(wh, 1.0f, 0), d23 = __builtin_amdgcn_cvt_scalef32_pk_f32_fp4(wh, 1.0f, 1);
            unsigned wl = __builtin_amdgcn_cvt_scalef32_pk_fp4_f32(0u, (x0 - d01.x) * 4.0f, (x1 - d01.y) * 4.0f, 1.0f, 0); wl = __builtin_amdgcn_cvt_scalef32_pk_fp4_f32(wl, (x2 - d23.x) * 4.0f, (x3 - d23.y) * 4.0f, 1.0f, 1);
            *(unsigned short*)(dst8 + (c0 >> 1)) = (unsigned short)wh; *(unsigned short*)(dst8 + 512 + (c0 >> 1)) = (unsigned short)wl; }
    }
}

__device__ __forceinline__ int f2sort(float f) { const int b = __float_as_int(f); return b ^ ((b >> 31) & 0x7fffffff); }
__device__ __forceinline__ float sort2f(int k) { return __int_as_float(k ^ ((k >> 31) & 0x7fffffff)); }
__device__ __forceinline__ void route_group(const Params& p, LAS float* sbuf, const int tg, const int h, const int lane) {
    const int r16 = lane & 15, q = lane >> 4;
    const bf16* QP = (const bf16*)(p.ws + WS_QP);
    const bf16* SK = (const bf16*)(p.ws + WS_SUBK16);
    int* ridx = (int*)(p.ws + WS_RIDX); float* rgate = (float*)(p.ws + WS_RGATE);
    {
        const int tok = tg * 64 + lane;
        int l1[16], l2[16];
#pragma unroll
        for (int c = 0; c < 2; ++c) {
            int lst[16];
#pragma unroll
            for (int k = 0; k < 16; ++k) lst[k] = (int)0x80000000;
#pragma unroll 1
            for (int kh = 0; kh < 2; ++kh) {
                u32x4 Aq[4][2];
#pragma unroll
                for (int mt = 0; mt < 4; ++mt)
#pragma unroll
                for (int ks_ = 0; ks_ < 2; ++ks_) Aq[mt][ks_] = *(const u32x4*)(QP + (size_t)(tg * 64 + 16 * mt + r16) * 1024 + h * 128 + c * 64 + 32 * ks_ + 8 * q);
                u32x4 Bk[4][2];
#pragma unroll
                for (int nt = 0; nt < 4; ++nt)
#pragma unroll
                    for (int ks_ = 0; ks_ < 2; ++ks_) Bk[nt][ks_] = *(const u32x4*)(SK + ((size_t)((h * 2 + c) * 128 + kh * 64 + 16 * nt + r16)) * 64 + 32 * ks_ + 8 * q);
#pragma unroll
                for (int mt = 0; mt < 4; ++mt)
#pragma unroll
                    for (int nt = 0; nt < 4; ++nt) { f32x4 acc = (f32x4){0.f, 0.f, 0.f, 0.f};
                        acc = __builtin_amdgcn_mfma_f32_16x16x32_bf16(__builtin_bit_cast(bf16x8, Aq[mt][0]), __builtin_bit_cast(bf16x8, Bk[nt][0]), acc, 0, 0, 0);
                        acc = __builtin_amdgcn_mfma_f32_16x16x32_bf16(__builtin_bit_cast(bf16x8, Aq[mt][1]), __builtin_bit_cast(bf16x8, Bk[nt][1]), acc, 0, 0, 0);
#pragma unroll
                        for (int r = 0; r < 4; ++r) sbuf[(16 * mt + 4 * q + r) * 68 + 16 * nt + r16] = acc[r]; }
                asm volatile("s_waitcnt lgkmcnt(0)" ::: "memory");
#pragma unroll 1
                for (int ch = 0; ch < 4; ++ch) {
                    int ck[16];
                    const int nb_ = 127 - kh * 64 - 16 * ch;
#pragma unroll
                    for (int n4 = 0; n4 < 4; ++n4) { const f32x4 s4 = *(const LAS f32x4*)(sbuf + lane * 68 + 16 * ch + 4 * n4);
#pragma unroll
                        for (int j = 0; j < 4; ++j) ck[4 * n4 + j] = (f2sort(s4[j]) & ~127) | (nb_ - (4 * n4 + j)); }
#pragma unroll
                    for (int k = 2; k <= 16; k <<= 1)
#pragma unroll
                        for (int j = k >> 1; j > 0; j >>= 1)
#pragma unroll
                            for (int i = 0; i < 16; ++i) { const int l = i ^ j; if (l > i) { const bool up = ((i & k) == 0) || k == 16; const int lo = min(ck[i], ck[l]), hi = max(ck[i], ck[l]); ck[i] = up ? lo : hi; ck[l] = up ? hi : lo; } }
#pragma unroll
                    for (int i = 0; i < 16; ++i) lst[i] = max(lst[i], ck[i]);
#pragma unroll
                    for (int j = 8; j > 0; j >>= 1)
#pragma unroll
                        for (int i = 0; i < 16; ++i) { const int l = i ^ j; if (l > i) { const int lo = min(lst[i], lst[l]), hi = max(lst[i], lst[l]); lst[i] = hi; lst[l] = lo; } }
                }
                asm volatile("s_waitcnt lgkmcnt(0)" ::: "memory");
            }
#pragma unroll
            for (int k = 0; k < 16; ++k) { if (c == 0) l1[k] = lst[k]; else l2[k] = lst[k]; }
        }
        float cs[16]; int cp[16];
        { const float v0 = sort2f(l1[0] & ~127); const int p0 = (127 - (l1[0] & 127)) << 7;
#pragma unroll
          for (int k = 0; k < 16; ++k) { cs[k] = v0 + sort2f(l2[k] & ~127); cp[k] = p0 | (127 - (l2[k] & 127)); } }
#pragma unroll
        for (int a = 1; a < 16; ++a)
#pragma unroll
            for (int bq = 0; bq < 16; ++bq) if ((a + 1) * (bq + 1) <= 16) {
                float v = sort2f(l1[a] & ~127) + sort2f(l2[bq] & ~127);
                int pay = ((127 - (l1[a] & 127)) << 7) | (127 - (l2[bq] & 127));
#pragma unroll
                for (int k = 0; k < 16; ++k) { const bool gt = v > cs[k]; const float tv = gt ? cs[k] : v; const int tp = gt ? cp[k] : pay; cs[k] = gt ? v : cs[k]; cp[k] = gt ? pay : cp[k]; v = tv; pay = tp; }
            }
        float e[16], sum = 0.f;
#pragma unroll
        for (int k = 0; k < 16; ++k) { e[k] = __expf(cs[k] - cs[0]); sum += e[k]; }
        const float rinv = 1.0f / sum;
        int tokw = tok; asm volatile("" : "+v"(tokw));
        const size_t ro = ((size_t)tokw * 8 + h) * 16;
#pragma unroll
        for (int k4 = 0; k4 < 4; ++k4) { *(int4*)(ridx + ro + 4 * k4) = make_int4(cp[4 * k4], cp[4 * k4 + 1], cp[4 * k4 + 2], cp[4 * k4 + 3]);
            *(f32x4*)(rgate + ro + 4 * k4) = (f32x4){e[4 * k4] * rinv, e[4 * k4 + 1] * rinv, e[4 * k4 + 2] * rinv, e[4 * k4 + 3] * rinv}; }
    }
}

__device__ __forceinline__ float gelu_tanh(float x) { const float z = 0.7978845608028654f * (x + 0.044715f * x * x * x); const float t = 1.0f - 2.0f * __builtin_amdgcn_rcpf(__expf(2.0f * z) + 1.0f); return 0.5f * x * (1.0f + t); }
__device__ __forceinline__ void unpack8(const u32x4 v, float (&o)[8]) { o[0] = bf_lo(v.x); o[1] = bf_hi(v.x); o[2] = bf_lo(v.y); o[3] = bf_hi(v.y); o[4] = bf_lo(v.z); o[5] = bf_hi(v.z); o[6] = bf_lo(v.w); o[7] = bf_hi(v.w); }
__device__ __forceinline__ void unpack_fp4x16(unsigned w0, unsigned w1, float (&o)[16]) {
    f32x2 t;
    t = __builtin_amdgcn_cvt_scalef32_pk_f32_fp4(w0, 1.0f, 0); o[0] = t.x; o[1] = t.y;   t = __builtin_amdgcn_cvt_scalef32_pk_f32_fp4(w0, 1.0f, 1); o[2] = t.x; o[3] = t.y;
    t = __builtin_amdgcn_cvt_scalef32_pk_f32_fp4(w0, 1.0f, 2); o[4] = t.x; o[5] = t.y;   t = __builtin_amdgcn_cvt_scalef32_pk_f32_fp4(w0, 1.0f, 3); o[6] = t.x; o[7] = t.y;
    t = __builtin_amdgcn_cvt_scalef32_pk_f32_fp4(w1, 1.0f, 0); o[8] = t.x; o[9] = t.y;   t = __builtin_amdgcn_cvt_scalef32_pk_f32_fp4(w1, 1.0f, 1); o[10] = t.x; o[11] = t.y;
    t = __builtin_amdgcn_cvt_scalef32_pk_f32_fp4(w1, 1.0f, 2); o[12] = t.x; o[13] = t.y; t = __builtin_amdgcn_cvt_scalef32_pk_f32_fp4(w1, 1.0f, 3); o[14] = t.x; o[15] = t.y;
}
__device__ __forceinline__ void unpack_fp4x16_v2(unsigned w0, unsigned w1, f32x2 (&o)[8]) {
    o[0] = __builtin_amdgcn_cvt_scalef32_pk_f32_fp4(w0, 1.0f, 0); o[1] = __builtin_amdgcn_cvt_scalef32_pk_f32_fp4(w0, 1.0f, 1);
    o[2] = __builtin_amdgcn_cvt_scalef32_pk_f32_fp4(w0, 1.0f, 2); o[3] = __builtin_amdgcn_cvt_scalef32_pk_f32_fp4(w0, 1.0f, 3);
    o[4] = __builtin_amdgcn_cvt_scalef32_pk_f32_fp4(w1, 1.0f, 0); o[5] = __builtin_amdgcn_cvt_scalef32_pk_f32_fp4(w1, 1.0f, 1);
    o[6] = __builtin_amdgcn_cvt_scalef32_pk_f32_fp4(w1, 1.0f, 2); o[7] = __builtin_amdgcn_cvt_scalef32_pk_f32_fp4(w1, 1.0f, 3);
}
template <int CTRL, int BANK> __device__ __forceinline__ float dpp_f(float oldv, float src) { return __int_as_float(__builtin_amdgcn_update_dpp(__float_as_int(oldv), __float_as_int(src), CTRL, 0xF, BANK, false)); }
__device__ __forceinline__ float reduce8(const float (&d)[8], int lane) {
    const bool b0 = lane & 1, b1 = lane & 2, b2 = lane & 4;
    float r[4];
#pragma unroll
    for (int m = 0; m < 4; ++m) { const float keep = b0 ? d[2 * m + 1] : d[2 * m], send = b0 ? d[2 * m] : d[2 * m + 1]; r[m] = keep + dpp_f<0xB1, 0xF>(0.f, send); }
    float s2[2];
#pragma unroll
    for (int m = 0; m < 2; ++m) { const float keep = b1 ? r[2 * m + 1] : r[2 * m], send = b1 ? r[2 * m] : r[2 * m + 1]; s2[m] = keep + dpp_f<0x4E, 0xF>(0.f, send); }
    const float keep = b2 ? s2[1] : s2[0], send = b2 ? s2[0] : s2[1];
    float t = dpp_f<0x104, 0x5>(0.f, send);
    t = dpp_f<0x114, 0xA>(t, send);
    float u = keep + t;
    u += dpp_f<0x128, 0xF>(0.f, u);
    u += __shfl_xor(u, 16);
    u += __shfl_xor(u, 32);
    return u;
}
typedef int v8i_t __attribute__((ext_vector_type(8)));
#ifndef USE_NT
#define USE_NT 0
#endif
#if USE_NT & 1
#define NT_LOAD(p_) __builtin_nontemporal_load(p_)
#else
#define NT_LOAD(p_) (*(p_))
#endif
#if USE_NT & 2
#define NT_STORE(v_, p_) __builtin_nontemporal_store(v_, p_)
#else
#define NT_STORE(v_, p_) (*(p_) = (v_))
#endif
#ifndef PROBE_CVT
#define PROBE_CVT 0
#endif
#if PROBE_CVT == 1
#define PROBE_CVT_EXTRA(a_, b_) do { f32x2 d0_, d1_, d2_, d3_; asm volatile("v_cvt_scalef32_pk_f32_fp4 %0, %4, 1.0\n\tv_cvt_scalef32_pk_f32_fp4 %1, %4, 1.0 op_sel:[1,0,0]\n\tv_cvt_scalef32_pk_f32_fp4 %2, %5, 1.0\n\tv_cvt_scalef32_pk_f32_fp4 %3, %5, 1.0 op_sel:[1,0,0]\n\t" \
        "v_cvt_scalef32_pk_f32_fp4 %0, %4, 1.0 op_sel:[0,1,0]\n\tv_cvt_scalef32_pk_f32_fp4 %1, %4, 1.0 op_sel:[1,1,0]\n\tv_cvt_scalef32_pk_f32_fp4 %2, %5, 1.0 op_sel:[0,1,0]\n\tv_cvt_scalef32_pk_f32_fp4 %3, %5, 1.0 op_sel:[1,1,0]" : "=&v"(d0_), "=&v"(d1_), "=&v"(d2_), "=&v"(d3_) : "v"(a_), "v"(b_)); } while (0)
#elif PROBE_CVT == 2
#define PROBE_CVT_EXTRA(a_, b_) do { f32x2 d0_, d1_, d2_, d3_; asm volatile("v_pk_mul_f32 %0, %4, %4\n\tv_pk_mul_f32 %1, %4, %4\n\tv_pk_mul_f32 %2, %4, %4\n\tv_pk_mul_f32 %3, %4, %4\n\t" \
        "v_pk_mul_f32 %0, %4, %4\n\tv_pk_mul_f32 %1, %4, %4\n\tv_pk_mul_f32 %2, %4, %4\n\tv_pk_mul_f32 %3, %4, %4" : "=&v"(d0_), "=&v"(d1_), "=&v"(d2_), "=&v"(d3_) : "v"(acc_)); } while (0)
#else
#define PROBE_CVT_EXTRA(a_, b_) do { } while (0)
#endif
#define EXP_LOADU(ua, idv_, gb_) do { int r16o_ = r16; asm volatile("" : "+v"(r16o_)); const int eid_ = __shfl((idv_), (gb_) + r16o_); const int uo_ = eid_ * 512 + 16 * q; \
        _Pragma("unroll") for (int ks_ = 0; ks_ < 8; ++ks_) ua[ks_] = __builtin_bit_cast(u32x4, __builtin_amdgcn_raw_buffer_load_b128(rsU, uo_ + 64 * ks_, 0, 0)); } while (0)
#define EXP_LOADV(vv, idv_, gb_) do { _Pragma("unroll") for (int j = 0; j < 16; ++j) { const int e_ = __builtin_amdgcn_readlane((idv_), (gb_) + j); vv[j] = __builtin_bit_cast(u32x2, __builtin_amdgcn_raw_buffer_load_b64(rsV, 8 * lane, e_ * 512, 0)); } } while (0)
#define EXP_COMPUTE(ua, vv, gv_, gb_, idn_, gbn_) do { f32x4 acc_ = (f32x4){0.f, 0.f, 0.f, 0.f}, accl_ = (f32x4){0.f, 0.f, 0.f, 0.f}; \
        _Pragma("unroll") for (int ks_ = 0; ks_ < 8; ++ks_) { const v8i_t a8 = {(int)ua[ks_].x, (int)ua[ks_].y, (int)ua[ks_].z, (int)ua[ks_].w, 0, 0, 0, 0}; \
            const u32x4 bh_ = xb_[ks_], bl_ = xb_[8 + ks_]; \
            const v8i_t b8h = {(int)bh_.x, (int)bh_.y, (int)bh_.z, (int)bh_.w, 0, 0, 0, 0}, b8l = {(int)bl_.x, (int)bl_.y, (int)bl_.z, (int)bl_.w, 0, 0, 0, 0}; \
            acc_ = __builtin_amdgcn_mfma_scale_f32_16x16x128_f8f6f4(a8, b8h, acc_, 4, 4, 0, 0, 0, 0); accl_ = __builtin_amdgcn_mfma_scale_f32_16x16x128_f8f6f4(a8, b8l, accl_, 4, 4, 0, 0, 0, 0); } \
        acc_ = acc_ + accl_ * 0.25f; \
        asm volatile("" ::: "memory"); \
        EXP_LOADU(ua, idn_, gbn_);            \
        float av_[4]; \
        int q4o_ = 4 * q; asm volatile("" : "+v"(q4o_)); \
        _Pragma("unroll") for (int r = 0; r < 4; ++r) av_[r] = gelu_tanh(acc_[r] * (1.0f / 84.0f)) * __shfl((gv_), (gb_) + q4o_ + r) * 0.2f; \
        _Pragma("unroll") for (int j = 0; j < 16; ++j) { const float a = rdlane(av_[j & 3], 16 * (j >> 2)); float t[16]; \
            unsigned w0_ = vv[j].x, w1_ = vv[j].y; asm volatile("" : "+v"(w0_), "+v"(w1_));        \
            PROBE_CVT_EXTRA(w0_, w1_); unpack_fp4x16(w0_, w1_, t);                                                            \
            _Pragma("unroll") for (int k = 0; k < 16; ++k) out[k] += a * t[k]; \
            asm volatile("" :: "v"(out[0]), "v"(out[1]), "v"(out[2]), "v"(out[3]), "v"(out[4]), "v"(out[5]), "v"(out[6]), "v"(out[7]), "v"(out[8]), "v"(out[9]), "v"(out[10]), "v"(out[11]), "v"(out[12]), "v"(out[13]), "v"(out[14]), "v"(out[15]) : "memory"); \
            { const int e_ = __builtin_amdgcn_readlane((idn_), (gbn_) + j); vv[j] = __builtin_bit_cast(u32x2, __builtin_amdgcn_raw_buffer_load_b64(rsV, 8 * lane, e_ * 512, 0)); } } } while (0)
__device__ __forceinline__ int claim_token(LAS int* qc, const int lane) {
    int t = 0;
    if (lane == 0) t = __hip_atomic_fetch_add(qc, 1, __ATOMIC_RELAXED, __HIP_MEMORY_SCOPE_WORKGROUP);
    return __builtin_amdgcn_readfirstlane(t);
}
__device__ __forceinline__ void experts_tokens(const Params& p, LAS unsigned char* xs8, LAS const float* g2fn, const int lane_in, const int tok_base, LAS int* qc) {
    int lane = lane_in;
    const int r16 = lane_in & 15, q = lane_in >> 4;
    const unsigned char* X8 = p.ws + WS_X8;
    const __amdgpu_buffer_rsrc_t rsU = __builtin_amdgcn_make_buffer_rsrc((void*)(p.ws + WS_PU), 0, 8 << 20, 0x00020000), rsV = __builtin_amdgcn_make_buffer_rsrc((void*)(p.ws + WS_PV), 0, 8 << 20, 0x00020000);
    const int* ridx = (const int*)(p.ws + WS_RIDX); const float* rgate = (const float*)(p.ws + WS_RGATE);
    const int c0_ = claim_token(qc, lane_in);
    if (c0_ >= 64) return;
    const int gw = tok_base + c0_;
    int idn0 = ridx[(size_t)gw * 128 + lane], idn1 = ridx[(size_t)gw * 128 + 64 + lane];
    float gn0 = rgate[(size_t)gw * 128 + lane], gn1 = rgate[(size_t)gw * 128 + 64 + lane];
    u32x4 xrow = *(const u32x4*)(X8 + (size_t)gw * 1024 + 16 * lane);
    u32x4 ua[8]; u32x2 vv[16];
    EXP_LOADU(ua, idn0, 0); asm volatile("" ::: "memory"); EXP_LOADV(vv, idn0, 0);
    for (int tok = gw;;) {
        asm volatile("" : "+v"(lane));
        const int id0 = idn0, id1 = idn1; const float g0 = gn0, g1 = gn1;
        int tokn = tok; bool more = false;
        { int lo16 = 16 * lane; asm volatile("" : "+v"(lo16)); *(LAS u32x4*)(xs8 + lo16) = xrow; }
        asm volatile("s_waitcnt lgkmcnt(0)" ::: "memory");
        u32x4 xb_[16];
#pragma unroll
        for (int ks_ = 0; ks_ < 8; ++ks_) { xb_[ks_] = *(const LAS u32x4*)(xs8 + 64 * ks_ + 16 * q); xb_[8 + ks_] = *(const LAS u32x4*)(xs8 + 512 + 64 * ks_ + 16 * q); }
        float out[16];
#pragma unroll
        for (int k = 0; k < 16; ++k) out[k] = 0.f;
#pragma unroll 1
        for (int g = 0; g < 7; ++g) {
            const int gn = g + 1;
            if (g == 5) { const int c_ = claim_token(qc, lane); more = c_ < 64; tokn = more ? tok_base + c_ : tok;
                idn0 = ridx[(size_t)tokn * 128 + lane]; idn1 = ridx[(size_t)tokn * 128 + 64 + lane]; gn0 = rgate[(size_t)tokn * 128 + lane]; gn1 = rgate[(size_t)tokn * 128 + 64 + lane];
                xrow = *(const u32x4*)(X8 + (size_t)tokn * 1024 + 16 * lane); }
            const int idvn = gn < 4 ? id0 : id1;
            const float gv = g < 4 ? g0 : g1;
            EXP_COMPUTE(ua, vv, gv, 16 * (g & 3), idvn, 16 * (gn & 3));
            __builtin_amdgcn_sched_barrier(0);
        }
        int l16 = 16 * lane; asm volatile("" : "+v"(l16));
        float* xr = p.out + (size_t)tok * 1024 + l16;
        f32x4 xv[4]; u32x4 yv[2];
        { const float* xs_ = p.in[I_X] + (size_t)tok * 1024 + l16; const bf16* ys_ = (const bf16*)(p.ws + WS_V) + (size_t)tok * 1024 + l16;
#pragma unroll
          for (int k4 = 0; k4 < 4; ++k4) xv[k4] = *(const f32x4*)(xs_ + 4 * k4);
          yv[0] = *(const u32x4*)ys_; yv[1] = *(const u32x4*)(ys_ + 8); }
        asm volatile("" ::: "memory");
        EXP_COMPUTE(ua, vv, g1, 48, idn0, 0);
        __builtin_amdgcn_sched_barrier(0);
#pragma unroll
        for (int k4 = 0; k4 < 4; ++k4) { const unsigned w0_ = yv[k4 >> 1][2 * (k4 & 1)], w1_ = yv[k4 >> 1][2 * (k4 & 1) + 1]; xv[k4] = xv[k4] + (f32x4){bf_lo(w0_), bf_hi(w0_), bf_lo(w1_), bf_hi(w1_)}; }
        float xn[16]; float ss = 0.f;
#pragma unroll
        for (int k4 = 0; k4 < 4; ++k4) { const f32x4 gg = *(LAS const f32x4*)(g2fn + l16 + 4 * k4);
#pragma unroll
            for (int j = 0; j < 4; ++j) { const float v = xv[k4][j] + gg[j] * out[4 * k4 + j]; xn[4 * k4 + j] = v; ss += v * v; } }
        ss = wave_sum_dpp(ss);
        const float rs = 1.0f / sqrtf(ss * (1.0f / 1024.0f) + EPSF);
#pragma unroll
        for (int k4 = 0; k4 < 4; ++k4) { const f32x4 nn = *(LAS const f32x4*)(g2fn + 1024 + l16 + 4 * k4);
            f32x4 o;
#pragma unroll
            for (int j = 0; j < 4; ++j) o[j] = xn[4 * k4 + j] * rs * nn[j];
            NT_STORE(o, (f32x4*)(xr + 4 * k4)); }
        if (!more) break;
        tok = tokn;
    }
}
#undef EXP_LOADU
#undef EXP_LOADV
#undef EXP_COMPUTE
#ifndef NEW_
#define NEW_ 6
#endif
__device__ __forceinline__ void route_experts_groups(const int wv, const Params& p, unsigned char* smem, const int g_first, const int g_count) {
    const int wave = wv;
    LAS unsigned char* xs8 = (LAS unsigned char*)smem + wave * 1024;
    LAS float* sbuf = (LAS float*)((LAS unsigned char*)smem + 8192 + wave * 17408);
    LAS int* qctr = (LAS int*)((LAS unsigned char*)smem + 8192 + 8 * 17408);
    LAS float* g2fn = (LAS float*)((LAS unsigned char*)smem + 8192 + 8 * 17408 + 256);
    { const int t_ = opaque_tid(wv); const float* mod = (const float*)(p.ws + WS_MOD);
      *(LAS f32x4*)(g2fn + 4 * t_) = t_ < 256 ? *(const f32x4*)(mod + ((g_first * 64) >> 13) * 6144 + 5120 + 4 * t_) : *(const f32x4*)(p.in[I_FNORM] + 4 * (t_ - 256)); }
    const int ngr = g_first + g_count;
    int g = g_first;
    if (g < ngr) route_group(p, sbuf, g, wave, opaque_tid(wv) & 63);
    if (opaque_tid(wv) == 0) { qctr[0] = 0; qctr[1] = 0; }
    asm volatile("s_waitcnt vmcnt(0) lgkmcnt(0)" ::: "memory"); __syncthreads();
#pragma unroll 1
    for (; g < ngr; ++g) {
        const int gn = g + 1;
        const int lane = opaque_tid(wv) & 63;
        const unsigned long long tp0_ = (PROBE_SEC == 27 || PROBE_SEC == 28) ? __builtin_amdgcn_s_memrealtime() : 0ull;
        if (wave >= NEW_ && gn < ngr) {
#pragma unroll 1
            for (int h = wave - NEW_; h < 8; h += 8 - NEW_) route_group(p, sbuf, gn, h, opaque_tid(wv) & 63); }
        experts_tokens(p, xs8, g2fn, opaque_tid(wv) & 63, g * 64, qctr + (g & 1));
        if (opaque_tid(wv) == 0) qctr[(g + 1) & 1] = 0;
        if ((PROBE_SEC == 27 && wave == 0 && lane == 0) || (PROBE_SEC == 28 && wave == NEW_ && lane == 0)) atomicAdd((unsigned long long*)(p.ws + WS_BAR) + blockIdx.x, __builtin_amdgcn_s_memrealtime() - tp0_);
        asm volatile("s_waitcnt vmcnt(0) lgkmcnt(0)" ::: "memory"); __syncthreads();
    }
}

__device__ __forceinline__ void ph2_inproj(const int wv, const Params& p, unsigned char* smem) {
    unsigned char* ws = p.ws;
    PG8_LAS unsigned char* lds = (PG8_LAS unsigned char*)smem;
    { pg8::Gemm g{(const pg8::bf16_t*)(ws + WS_A), (const pg8::bf16_t*)(ws + WS_WINT), NTOK, PROJW, DM};
      pg8::StaticOrder S; S.init(NTOK, PROJW, gridDim.x, blockIdx.x);
      static_assert(WS_G == WS_V + (size_t)NTOK * 1024 * 2, "V and G must be contiguous");
      EpiInProj E{(bf16*)(ws + WS_ZT), (bf16*)(ws + WS_QK), (bf16*)(ws + WS_V), (bf16*)p.out, (const float2*)(ws + WS_ROT)};
      pg8::gemm_phase<EpiInProj, pg8::StaticOrder, false>(lds, g, S, E, PG8_PROBE_PTR, wv); }
    { pg8::Gemm g{(const pg8::bf16_t*)(ws + WS_HCTX), (const pg8::bf16_t*)(ws + WS_WINT) + (size_t)3584 * 1024, NCTX, 1536, DM};
      pg8::StaticOrder S; S.init(NCTX, 1536, gridDim.x, blockIdx.x);
      EpiCtx E{(bf16*)(ws + WS_CK), (bf16*)(ws + WS_CV)};
      pg8::gemm_phase<EpiCtx, pg8::StaticOrder, false>(lds, g, S, E, PG8_PROBE_PTR, wv); }
    { constexpr int NCT = (NCTX / 256) * (1536 / 256);
      if ((int)gridDim.x > NCT) { if ((int)blockIdx.x >= NCT) convert_expert_tables(wv, p, NCT, (int)gridDim.x - NCT); }
      else convert_expert_tables(wv, p, 0, (int)gridDim.x); }
}
struct PanelOrder {
    int pm, nN;
    __device__ __forceinline__ bool next(int i, pg8::Unit& u) const { if (i >= nN) return false; u.pm = pm; u.pn = i; return true; }
    __device__ __forceinline__ void a_ready(const pg8::Unit&) const {}
    __device__ __forceinline__ void done(const pg8::Unit&) const {}
};
#define BLOCK_SEAM() do { asm volatile("s_waitcnt vmcnt(0)" ::: "memory"); __syncthreads(); } while (0)
__device__ __forceinline__ void ph_tail(const int wv, const Params& p, unsigned char* smem) {
    unsigned char* ws = p.ws;
    PG8_LAS unsigned char* lds = (PG8_LAS unsigned char*)smem;
    { const int pm = blockIdx.x;
        SEC_BEGIN(21);
        readout_items(wv, p, pm * 1024, pm * 1024 + 1024, wv, 8);
        BLOCK_SEAM();
        SEC_END(21, ws); SEC_BEGIN(22);
        { pg8::Gemm g{(const pg8::bf16_t*)(ws + WS_YH), (const pg8::bf16_t*)(ws + WS_WHYT), NTOK, DM, DM};
          PanelOrder S{pm, 4};
          EpiMerge<0> E{(bf16*)(ws + WS_M), (const bf16*)p.out};
          pg8::gemm_phase<EpiMerge<0>, PanelOrder, false>(lds, g, S, E, PG8_PROBE_PTR, wv); }
        SEC_END(22, ws); SEC_BEGIN(23);
        { pg8::Gemm g{(const pg8::bf16_t*)(ws + WS_OF), (const pg8::bf16_t*)(ws + WS_WRETT), NTOK, DM, DM};
          PanelOrder S{pm, 4};
          EpiMerge<1> E{(bf16*)(ws + WS_M), (const bf16*)p.out + 262144};
          pg8::gemm_phase<EpiMerge<1>, PanelOrder, false>(lds, g, S, E, PG8_PROBE_PTR, wv); }
        BLOCK_SEAM();
        SEC_END(23, ws); SEC_BEGIN(24);
        { pg8::Gemm g{(const pg8::bf16_t*)(ws + WS_M), (const pg8::bf16_t*)(ws + WS_WOT), NTOK, DM, DM};
          PanelOrder S{pm, 4};
          EpiY E{(bf16*)(ws + WS_V), (const float*)(ws + WS_MOD)};
          pg8::gemm_phase<EpiY, PanelOrder, false>(lds, g, S, E, PG8_PROBE_PTR, wv); }
        BLOCK_SEAM();
        SEC_END(24, ws); SEC_BEGIN(25);
        rows2_range(wv, p, pm * 256, pm * 256 + 256);
        BLOCK_SEAM();
        SEC_END(25, ws); SEC_BEGIN(26);
        { pg8::Gemm g{(const pg8::bf16_t*)(ws + WS_H2), (const pg8::bf16_t*)(ws + WS_WQT), NTOK, DM, DM};
          PanelOrder S{pm, 4};
          pg8::EpiBf16<0> E{(pg8::bf16_t*)(ws + WS_QP), DM, nullptr, 0, 0};
          pg8::gemm_phase<pg8::EpiBf16<0>, PanelOrder, false>(lds, g, S, E, PG8_PROBE_PTR, wv); }
        BLOCK_SEAM();
        SEC_END(26, ws); SEC_BEGIN(29);
        route_experts_groups(wv, p, smem, pm * 4, 4);
        BLOCK_SEAM();
        SEC_END(29, ws);
    }
}

#define XB_TMO      128
#define XB_XCNT(j)  (256  + 64 * (j))
#define XB_XSUB(j)  (1280 + 64 * (j))
#define XB_XGEN(j)  (2304 + 64 * (j))
#define XB_TOP      3328
#define XB_TOPGEN   3392
#define XCD_BAR_WORDS 3456
#define XB_SPIN_CAP (1u << 22)
__device__ __forceinline__ unsigned xb_ld(unsigned* p)              { return __hip_atomic_load(p, __ATOMIC_RELAXED, __HIP_MEMORY_SCOPE_AGENT); }
__device__ __forceinline__ unsigned xb_add(unsigned* p, unsigned v) { return __hip_atomic_fetch_add(p, v, __ATOMIC_RELAXED, __HIP_MEMORY_SCOPE_AGENT); }
__device__ __forceinline__ unsigned xb_xcc_id() { return (unsigned)__builtin_amdgcn_s_getreg((3 << 11) | 20) & 0xFu; }
#define XB_SPIN(cond, bar) do { unsigned _sp = 0; while (cond) { __builtin_amdgcn_s_sleep(1); \
    if ((++_sp & 255u) == 0u) { if (xb_ld(&(bar)[XB_TMO])) break; if (_sp > XB_SPIN_CAP) { atomicAdd(&(bar)[XB_TMO], 1u); break; } } } } while (0)
struct XcdBarrier { unsigned* bar; unsigned x; unsigned nloc, nx; };
__device__ __forceinline__ void xcd_barrier_post(XcdBarrier& b, unsigned* bar) {
    b.bar = bar; b.x = xb_xcc_id(); b.nloc = 0u; b.nx = 0u;
    if (threadIdx.x == 0) (void)xb_add(&bar[XB_XCNT(b.x)], 1u);
}
__device__ __forceinline__ void xcd_barrier_complete(unsigned* bar, unsigned x, unsigned& nloc, unsigned& nx) {
    const unsigned G = gridDim.x * gridDim.y * gridDim.z;
    unsigned sum, cnt, mine, sp = 0u;
    for (;;) {
        sum = 0u; cnt = 0u; mine = 0u;
#pragma unroll
        for (unsigned j = 0; j < 16; ++j) { const unsigned c = xb_ld(&bar[XB_XCNT(j)]); sum += c; cnt += (c > 0u) ? 1u : 0u; mine = (j == x) ? c : mine; }
        if (sum == G) break;
        __builtin_amdgcn_s_sleep(1);
        if ((++sp & 255u) == 0u) { if (xb_ld(&bar[XB_TMO])) break; if (sp > XB_SPIN_CAP) { atomicAdd(&bar[XB_TMO], 1u); break; } }
    }
    nloc = mine > 0u ? mine : 1u; nx = cnt > 0u ? cnt : 1u;
}
__device__ __forceinline__ void xcd_barrier(XcdBarrier& b) {
    asm volatile("s_waitcnt vmcnt(0)" ::: "memory");
    __syncthreads();
    if (threadIdx.x == 0) {
        unsigned* bar = b.bar;
        __builtin_amdgcn_s_waitcnt(0);
        if (b.nloc == 0u) xcd_barrier_complete(bar, b.x, b.nloc, b.nx);
        const unsigned nloc = b.nloc, nx = b.nx;
        const unsigned old = xb_add(&bar[XB_XSUB(b.x)], 1u);
        const unsigned gen = old / nloc;
        if (old + 1u == (gen + 1u) * nloc) {
            __builtin_amdgcn_fence(__ATOMIC_RELEASE, "agent");
            asm volatile("s_waitcnt vmcnt(0)" ::: "memory");
            const unsigned og = xb_add(&bar[XB_TOP], 1u);
            const unsigned tg = og / nx;
            if (og + 1u == (tg + 1u) * nx) xb_add(&bar[XB_TOPGEN], 1u);
            else XB_SPIN(xb_ld(&bar[XB_TOPGEN]) == tg, bar);
            __builtin_amdgcn_fence(__ATOMIC_ACQUIRE, "agent");
            xb_add(&bar[XB_XGEN(b.x)], 1u);
            asm volatile("s_waitcnt vmcnt(0)" ::: "memory");
        } else {
            XB_SPIN(xb_ld(&bar[XB_XGEN(b.x)]) == gen, bar);
            __builtin_amdgcn_fence(__ATOMIC_ACQUIRE, "agent");
            asm volatile("s_waitcnt vmcnt(0)" ::: "memory");
        }
    }
    __syncthreads();
}

#ifndef ONE_LAUNCH
#define ONE_LAUNCH 1
#endif
template <int PH> __device__ __forceinline__ void run_phase(const int wv, const Params& p, unsigned char* smem) {
    if (PH == 0) ph0_prologue(wv, p, smem);
    if (PH == 1) ph1_rows_and_taps(wv, p, smem);
    if (PH == 2) ph2_inproj(wv, p, smem);
    if (PH == 3) { if (wv >= 4) __builtin_amdgcn_s_setprio(1);
                   ph3a_filter_spectrum(wv, p, smem); BLOCK_SEAM(); ph3b_hyena_fftconv(wv, p, smem); __builtin_amdgcn_s_setprio(0); }
    if (PH == 4) { if (wv >= 4) __builtin_amdgcn_s_setprio(1);
                   ph4_retention(wv, p, smem); __builtin_amdgcn_s_setprio(0); { SEC_BEGIN(7); ph4_transpose_yh(wv, p, smem); SEC_END(7, p.ws); } }
    if (PH == 11) ph_tail(wv, p, smem);
}
#if ONE_LAUNCH
#ifndef PROBE_PH
#define PROBE_PH (-1)
#endif
#ifndef PROBE_SYNC
#define PROBE_SYNC 0
#endif
#ifndef USE_XCD_BARRIER
#define USE_XCD_BARRIER 0
#endif
#ifndef PROBE_CLK
#define PROBE_CLK 0
#endif
#define RUN_PHASE(PH) do { const unsigned long long t0_ = (PROBE_PH == (PH)) ? (PROBE_CLK ? (unsigned long long)__builtin_readcyclecounter() / 21ull : __builtin_amdgcn_s_memrealtime()) : 0ull; run_phase<PH>(wv, p, smem); if (!USE_XCD_BARRIER || (PH) == 0) grid.sync(); else xcd_barrier(xb); \
        if (PROBE_PH == (PH)) { const unsigned long long t1c_ = PROBE_CLK ? (unsigned long long)__builtin_readcyclecounter() / 21ull : 0ull; const unsigned long long t1_ = __builtin_amdgcn_s_memrealtime(); const unsigned long long dt_ = 3ull * ((PROBE_CLK ? t1c_ : t1_) - t0_); \
            while (__builtin_amdgcn_s_memrealtime() - t1_ < dt_) __builtin_amdgcn_s_sleep(64); } } while (0)
__global__ void __launch_bounds__(NTHR, 2) fwd_megakernel(Params p) {
    extern __shared__ __attribute__((aligned(16))) unsigned char smem[];
    cg::grid_group grid = cg::this_grid();
    const int wv = __builtin_amdgcn_readfirstlane(threadIdx.x >> 6);
    XcdBarrier xb; if (USE_XCD_BARRIER) xcd_barrier_post(xb, (unsigned*)(p.ws + WS_BAR));
    RUN_PHASE(0); RUN_PHASE(1); RUN_PHASE(2); RUN_PHASE(3); RUN_PHASE(4);
#if PROBE_SYNC
    for (int i_ = 0; i_ < 16; ++i_) grid.sync();
#endif
#if PROBE_SEC >= 0
    run_phase<11>(wv, p, smem);
    { __syncthreads(); const unsigned long long acc_ = __hip_atomic_load((unsigned long long*)(p.ws + WS_BAR) + blockIdx.x, __ATOMIC_RELAXED, __HIP_MEMORY_SCOPE_AGENT);
      const unsigned long long t1_ = __builtin_amdgcn_s_memrealtime(); while (__builtin_amdgcn_s_memrealtime() - t1_ < 3ull * acc_) __builtin_amdgcn_s_sleep(64); }
#elif PROBE_PH == 11
    { const unsigned long long t0_ = __builtin_amdgcn_s_memrealtime(); run_phase<11>(wv, p, smem); const unsigned long long t1_ = __builtin_amdgcn_s_memrealtime(); const unsigned long long dt_ = 3ull * (t1_ - t0_);
      while (__builtin_amdgcn_s_memrealtime() - t1_ < dt_) __builtin_amdgcn_s_sleep(64); }
#else
    run_phase<11>(wv, p, smem);
#endif
}
#else
template <int PH> __global__ void __launch_bounds__(NTHR, 2) k_phase(Params p) {
    extern __shared__ __attribute__((aligned(16))) unsigned char smem[];
    const int wv = __builtin_amdgcn_readfirstlane(threadIdx.x >> 6);
    run_phase<PH>(wv, p, smem);
}
#endif

extern "C" void kernel_launch(void* const* d_in, const int* in_sizes, int n_in, void* d_out, int out_size, void* d_ws, size_t ws_size, hipStream_t stream) {
    static int grid = 0;
    if (grid == 0) {
        if (n_in != 31 || out_size != NTOK * DM || ws_size < WS_END) { fprintf(stderr, "kernel_launch: unexpected shapes (n_in %d out %d ws %zu)\n", n_in, out_size, ws_size); grid = -1; return; }
        int dev = 0, cus = 0;
        hipGetDevice(&dev); hipDeviceGetAttribute(&cus, hipDeviceAttributeMultiprocessorCount, dev);
#if ONE_LAUNCH
        int per_cu = 0;
        hipFuncSetAttribute((const void*)fwd_megakernel, hipFuncAttributeMaxDynamicSharedMemorySize, LDS_BYTES);
        hipOccupancyMaxActiveBlocksPerMultiprocessor(&per_cu, (const void*)fwd_megakernel, NTHR, LDS_BYTES);
        if (per_cu < 1) { fprintf(stderr, "kernel_launch: occupancy query says %d blocks/CU\n", per_cu); per_cu = 1; }
        if (cus != NTOK / 256) { fprintf(stderr, "kernel_launch: built for a %d-CU device (one 256-token panel per workgroup); this device reports %d CUs\n", NTOK / 256, cus); grid = -1; return; }
        grid = cus;
#else
#define SETATTR(PH) hipFuncSetAttribute((const void*)k_phase<PH>, hipFuncAttributeMaxDynamicSharedMemorySize, LDS_BYTES)
        SETATTR(0); SETATTR(1); SETATTR(2); SETATTR(3); SETATTR(4); SETATTR(5); SETATTR(6); SETATTR(7); SETATTR(8); SETATTR(9); SETATTR(10); SETATTR(11); SETATTR(12);
#undef SETATTR
        grid = cus;
#endif
        (void)hipGetLastError();
    }
    if (grid < 0) return;
    Params p{};
    for (int i = 0; i < 31; ++i) p.in[i] = (const float*)d_in[i];
    p.out = (float*)d_out; p.ws = (unsigned char*)d_ws;
#if ONE_LAUNCH
#if USE_XCD_BARRIER || PROBE_SEC >= 0
    (void)hipMemsetAsync((unsigned char*)d_ws + WS_BAR, 0, XCD_BAR_WORDS * 4, stream);
#endif
    void* args[] = {&p};
    hipError_t e = hipLaunchCooperativeKernel((const void*)fwd_megakernel, dim3(grid), dim3(NTHR), args, LDS_BYTES, stream);
    if (e != hipSuccess) fprintf(stderr, "cooperative launch failed: %s (grid %d)\n", hipGetErrorString(e), grid);
#else
#define LAUNCH(PH) hipLaunchKernelGGL(k_phase<PH>, dim3(grid), dim3(NTHR), LDS_BYTES, stream, p)
    LAUNCH(0); LAUNCH(1); LAUNCH(2); LAUNCH(3); LAUNCH(4); LAUNCH(5); LAUNCH(6); LAUNCH(7); LAUNCH(8); LAUNCH(9); LAUNCH(10); LAUNCH(11);
#undef LAUNCH
#endif
}
```
